# Optimizing an MI355X kernel written in HIP

```python
import math
import jax, jax.numpy as jnp
from jax import lax
import numpy as np

D_MODEL = 1024
BATCH = 4
SEQ = 8192
DEPTH = 1

D_MIX = D_MODEL
MLA_HEADS = 8
MLA_NOPE = 64
MLA_ROPE = 32
MLA_V = 64
MLA_WIDTH = MLA_HEADS * MLA_V
Q_LORA = 256
KV_LORA = 128
ROPE_THETA = 10000.0
Q_BLOCK = 128
CHUNK = 128
G_HEADS = 8
G_WIDTH = D_MIX - MLA_WIDTH
G_HEAD_DIM = G_WIDTH // G_HEADS
D_IN = Q_LORA + KV_LORA + MLA_ROPE + MLA_WIDTH + 3 * G_WIDTH
DN_ALPHA = (2.0 * DEPTH) ** 0.25
DN_BETA = (8.0 * DEPTH) ** -0.25
EPS = 1e-5

kernel_name = "hybrid_mla_gmlp_parallel_deepnorm"


def _rmsnorm(x, g):
    xf = x.astype(jnp.float32)
    y = xf * lax.rsqrt(jnp.mean(xf * xf, axis=-1, keepdims=True) + EPS)
    return (y * g.astype(jnp.float32)).astype(x.dtype)


def _layernorm(x, g, b):
    xf = x.astype(jnp.float32)
    mu = jnp.mean(xf, axis=-1, keepdims=True)
    var = jnp.mean(jnp.square(xf - mu), axis=-1, keepdims=True)
    y = (xf - mu) * lax.rsqrt(var + EPS)
    return (y * g.astype(jnp.float32) + b.astype(jnp.float32)).astype(x.dtype)


def _rope(t, positions):
    half = MLA_ROPE // 2
    inv_freq = 1.0 / (ROPE_THETA ** (jnp.arange(half, dtype=jnp.float32) / half))
    ang = positions.astype(jnp.float32)[..., None] * inv_freq
    cos = jnp.cos(ang)[:, :, None, :].astype(t.dtype)
    sin = jnp.sin(ang)[:, :, None, :].astype(t.dtype)
    t1, t2 = t[..., :half], t[..., half:]
    return jnp.concatenate([t1 * cos - t2 * sin, t1 * sin + t2 * cos], axis=-1)


def _causal_attention(q, k, v):
    b, s, h, dqk = q.shape
    dv = v.shape[-1]
    nb = s // Q_BLOCK
    scale = 1.0 / math.sqrt(dqk)
    qb = q.reshape(b, nb, Q_BLOCK, h, dqk).transpose(1, 0, 2, 3, 4)
    kpos = jnp.arange(s)

    def one_block(args):
        qi, i = args
        sc = jnp.einsum('bqhd,bkhd->bhqk', qi, k).astype(jnp.float32) * scale
        qpos = i * Q_BLOCK + jnp.arange(Q_BLOCK)
        mask = kpos[None, :] <= qpos[:, None]
        sc = jnp.where(mask[None, None], sc, -jnp.inf)
        p = jax.nn.softmax(sc, axis=-1).astype(v.dtype)
        return jnp.einsum('bhqk,bkhd->bqhd', p, v)

    o = lax.map(one_block, (qb, jnp.arange(nb)))
    return o.transpose(1, 0, 2, 3, 4).reshape(b, s, h, dv)


def setup_inputs(seed: int = 0) -> dict:
    key = jax.random.key(seed)
    ks = jax.random.split(key, 16)
    f32 = jnp.float32
    x = jax.random.normal(ks[0], (BATCH, SEQ, D_MODEL), f32)
    positions = jnp.broadcast_to(jnp.arange(SEQ, dtype=jnp.int32)[None, :], (BATCH, SEQ))
    w_in = jax.random.normal(ks[1], (D_MODEL, D_IN), f32) * D_MODEL ** -0.5
    q_norm_g = 1.0 + 0.02 * jax.random.normal(ks[2], (Q_LORA,), f32)
    w_uq = jax.random.normal(ks[3], (Q_LORA, MLA_HEADS * (MLA_NOPE + MLA_ROPE)), f32) * Q_LORA ** -0.5
    kv_norm_g = 1.0 + 0.02 * jax.random.normal(ks[4], (KV_LORA,), f32)
    w_ukv = jax.random.normal(ks[5], (KV_LORA, MLA_HEADS * (MLA_NOPE + MLA_V)), f32) * KV_LORA ** -0.5
    sgu_norm_g = 1.0 + 0.02 * jax.random.normal(ks[6], (G_WIDTH,), f32)
    sgu_norm_b = 0.02 * jax.random.normal(ks[7], (G_WIDTH,), f32)
    w_spatial = jax.random.normal(ks[8], (G_HEADS, CHUNK, CHUNK), f32) * CHUNK ** -0.5
    b_spatial = 1.0 + 0.02 * jax.random.normal(ks[9], (G_HEADS, CHUNK), f32)
    w_out = jax.random.normal(ks[10], (D_MIX, D_MODEL), f32) * (D_MIX ** -0.5) * DN_BETA
    ln_g = 1.0 + 0.02 * jax.random.normal(ks[11], (D_MODEL,), f32)
    ln_b = 0.02 * jax.random.normal(ks[12], (D_MODEL,), f32)
    return {"x": x, "positions": positions, "w_in": w_in, "q_norm_g": q_norm_g,
            "w_uq": w_uq, "kv_norm_g": kv_norm_g, "w_ukv": w_ukv,
            "sgu_norm_g": sgu_norm_g, "sgu_norm_b": sgu_norm_b,
            "w_spatial": w_spatial, "b_spatial": b_spatial, "w_out": w_out,
            "ln_g": ln_g, "ln_b": ln_b}


def _hybrid_mixer(h, positions, w_in, q_norm_g, w_uq, kv_norm_g, w_ukv,
                  sgu_norm_g, sgu_norm_b, w_spatial, b_spatial, w_out):
    b, s, _ = h.shape
    proj = jnp.einsum('bsd,de->bse', h, w_in)
    splits = np.cumsum([Q_LORA, KV_LORA, MLA_ROPE, MLA_WIDTH, G_WIDTH, G_WIDTH]).tolist()
    c_q, c_kv, k_rope, z_a, u, v = jnp.split(proj, splits, axis=-1)[:6]
    z_b = proj[..., splits[-1]:]

    q = jnp.einsum('bsr,re->bse', _rmsnorm(c_q, q_norm_g), w_uq)
    q = q.reshape(b, s, MLA_HEADS, MLA_NOPE + MLA_ROPE)
    q_nope, q_rope = q[..., :MLA_NOPE], _rope(q[..., MLA_NOPE:], positions)
    kv = jnp.einsum('bsr,re->bse', _rmsnorm(c_kv, kv_norm_g), w_ukv)
    kv = kv.reshape(b, s, MLA_HEADS, MLA_NOPE + MLA_V)
    k_nope, val = kv[..., :MLA_NOPE], kv[..., MLA_NOPE:]
    k_r = jnp.broadcast_to(_rope(k_rope[:, :, None, :], positions), (b, s, MLA_HEADS, MLA_ROPE))
    qf = jnp.concatenate([q_nope, q_rope], axis=-1)
    kf = jnp.concatenate([k_nope, k_r], axis=-1)
    attn = _causal_attention(qf, kf, val).reshape(b, s, MLA_WIDTH)
    out_a = attn * jax.nn.silu(z_a)

    u = jax.nn.gelu(u, approximate=False)
    v = _layernorm(jax.nn.gelu(v, approximate=False), sgu_norm_g, sgu_norm_b)
    nc = s // CHUNK
    vc = v.reshape(b, nc, CHUNK, G_HEADS, G_HEAD_DIM)
    causal = jnp.tril(jnp.ones((CHUNK, CHUNK), dtype=bool))
    w_s = jnp.where(causal[None], w_spatial, 0.0).astype(v.dtype)
    sv = jnp.einsum('hts,bcshd->bcthd', w_s, vc) + b_spatial.T[None, None, :, :, None]
    sgu = u * sv.reshape(b, s, G_WIDTH)
    out_b = sgu * jax.nn.silu(z_b)

    merged = jnp.concatenate([out_a, out_b], axis=-1)
    return jnp.einsum('bse,ed->bsd', merged, w_out)


def reference(x, positions, w_in, q_norm_g, w_uq, kv_norm_g, w_ukv,
              sgu_norm_g, sgu_norm_b, w_spatial, b_spatial, w_out, ln_g, ln_b):
    h = x
    for _ in range(DEPTH):
        y = _hybrid_mixer(h, positions, w_in, q_norm_g, w_uq, kv_norm_g, w_ukv,
                          sgu_norm_g, sgu_norm_b, w_spatial, b_spatial, w_out)
        h = _layernorm(DN_ALPHA * h + y, ln_g, ln_b)
    return h
```

```cpp
#include <hip/hip_runtime.h>
#include <hip/hip_cooperative_groups.h>
#include <cstdio>
#include <cstdint>
namespace cg = cooperative_groups;
namespace pg8 {
#define PG8_LAS __attribute__((address_space(3)))
typedef unsigned short bf16_t;
typedef short bf16x8 __attribute__((ext_vector_type(8)));
typedef float f32x4 __attribute__((ext_vector_type(4)));
typedef unsigned u32x4 __attribute__((ext_vector_type(4)));
constexpr int BM = 256, BK = 64, HALF = 128, HTB = HALF * BK * 2  , STAGE_BYTES = 8 * HTB, NXCD = 8, WGM = 8;

__host__ __device__ __forceinline__ int lds_byte(int r, int c) { const int st = (r >> 4) * 2 + (c >> 5), rr = r & 15, cc = c & 31, ob = rr * 64 + cc * 2; return st * 1024 + (ob ^ (((ob >> 9) & 1) << 5)); }
__host__ __device__ __forceinline__ void stage_rc(int b, int& R, int& C) { const int st = b / 1024, sb = b % 1024, swz = sb ^ (((sb >> 9) & 1) << 5); R = (st >> 1) * 16 + swz / 64; C = (st & 1) * 32 + (swz % 64) / 2; }
__host__ __device__ __forceinline__ int perm32(int rho) { const int n = rho >> 4, i = rho & 15; return 8 * (i >> 2) + 4 * n + (i & 3); }

struct Unit { int pm, pn; };
struct Gemm { const bf16_t* A; const bf16_t* Bt; int M, N, K; };

struct StaticOrder {
    int nM, nN, nwg, G, c;
    __host__ __device__ void init(int M, int N, int G_, int c_) { nM = M / BM; nN = N / BM; nwg = nM * nN; G = G_; c = c_; }
    __host__ __device__ bool next(int i, Unit& u) const {
        const long L = (long)i * G + c; if (L >= nwg) return false;
        int wgid = (int)L; { const int q = nwg / NXCD, r = nwg % NXCD, xcd = wgid % NXCD, off = wgid / NXCD; wgid = (xcd < r ? xcd * (q + 1) : r * (q + 1) + (xcd - r) * q) + off; }
        const int nig = WGM * nN, gid = wgid / nig, fm = gid * WGM, gsz = (nM - fm) < WGM ? (nM - fm) : WGM;
        u.pm = fm + ((wgid % nig) % gsz); u.pn = (wgid % nig) / gsz; return true;
    }
    __device__ __forceinline__ void a_ready(const Unit&) const {}
    __device__ __forceinline__ void done(const Unit&) const {}
};

__device__ __forceinline__ unsigned cvt_pk_bf16(float lo, float hi) { unsigned r; asm volatile("v_cvt_pk_bf16_f32 %0, %1, %2" : "=v"(r) : "v"(lo), "v"(hi)); return r; }
typedef float f32x2 __attribute__((ext_vector_type(2)));
__device__ __forceinline__ f32x2 gelu_pk(f32x2 v) {
    const f32x2 av = __builtin_elementwise_abs(v), d = av * 0.2316418882f + 1.0f;
    f32x2 t; t.x = __builtin_amdgcn_rcpf(d.x); t.y = __builtin_amdgcn_rcpf(d.y);
    f32x2 q = t * 0.5307027145f + (-0.7265760135f); q = q * t + 0.7107068705f; q = q * t + (-0.142248368f); q = q * t + 0.127414796f; q = q * t;
    const f32x2 s = (v * v) * (-0.72134752044f);
    f32x2 e; e.x = __builtin_amdgcn_exp2f(s.x); e.y = __builtin_amdgcn_exp2f(s.y);
    const f32x2 m = v * (q * e), r = v - m;
    f32x2 o; o.x = v.x < 0.f ? m.x : r.x; o.y = v.y < 0.f ? m.y : r.y; return o;
}

template <int ACT  > struct EpiBf16 {
    static constexpr bool PERM = true, AFTER_DRAIN = false; static_assert(ACT == 0 || ACT == 1, "EpiBf16: ACT is 0 (none) or 1 (gelu_pk)");
    bf16_t* O; int ldc; const float* bias; int split_cols; size_t split_stride; float scale0;
    __device__ __forceinline__ void operator()(const f32x4 (&acc)[2][2][4][2], const Unit& u, int wr, int wc, int fr, int fq) const {
        const int row0 = u.pm * BM + wr * 64 + fr; int colt = u.pn * BM; bf16_t* base = O;
        float sc = 1.f; if (split_cols) { const int t = colt / split_cols; base += (size_t)t * split_stride; colt -= t * split_cols; if (t == 0) sc = scale0; }
        const int col0 = colt + wc * 32 + 8 * fq, bcol0 = u.pn * BM + wc * 32 + 8 * fq;
        f32x4 bv[2][2];
#pragma unroll
        for (int bj = 0; bj < 2; ++bj)
#pragma unroll
            for (int n = 0; n < 2; ++n) bv[bj][n] = bias ? *(const f32x4*)(bias + bcol0 + bj * HALF + 4 * n) : (f32x4){0.f, 0.f, 0.f, 0.f};
#pragma unroll
        for (int ai = 0; ai < 2; ++ai)
#pragma unroll
            for (int m = 0; m < 4; ++m) { bf16_t* rowp = base + (size_t)(row0 + ai * HALF + m * 16) * ldc + col0;
#pragma unroll
                for (int bj = 0; bj < 2; ++bj) { f32x4 v0 = acc[ai][bj][m][0] + bv[bj][0], v1 = acc[ai][bj][m][1] + bv[bj][1];
                    if (ACT == 1) { f32x2 a = gelu_pk((f32x2){v0[0], v0[1]}), b = gelu_pk((f32x2){v0[2], v0[3]}), c = gelu_pk((f32x2){v1[0], v1[1]}), d = gelu_pk((f32x2){v1[2], v1[3]});
                        v0 = (f32x4){a.x, a.y, b.x, b.y}; v1 = (f32x4){c.x, c.y, d.x, d.y}; }
                    v0 = v0 * sc; v1 = v1 * sc; u32x4 w; w.x = cvt_pk_bf16(v0[0], v0[1]); w.y = cvt_pk_bf16(v0[2], v0[3]); w.z = cvt_pk_bf16(v1[0], v1[1]); w.w = cvt_pk_bf16(v1[2], v1[3]);
                    *(u32x4*)(rowp + bj * HALF) = w; } }
    }
};
template <class Epi, class Sched, bool ALIGN_EPI = false, bool SP2 = false>
__device__ __forceinline__ void gemm_phase(PG8_LAS unsigned char* lds, const Gemm g, const Sched& S, const Epi& E) {
    int tid_ = threadIdx.x; asm volatile("" : "+v"(tid_));
    const int tid = tid_, wid = __builtin_amdgcn_readfirstlane(tid >> 6), lane = tid & 63, wr = wid >> 2, wc = wid & 3, fr = lane & 15, fq = lane >> 4;
    const int K = g.K, nt = K / BK;
    unsigned voffA[2], voffB[2];
#pragma unroll
    for (int i = 0; i < 2; ++i) { int R, C; stage_rc(tid * 16 + i * 8192, R, C); const int Rb = Epi::PERM ? ((R & ~31) + perm32(R & 31)) : R;
        voffA[i] = (unsigned)(R * K + C) * 2u; voffB[i] = (unsigned)(Rb * K + C) * 2u; }
    const size_t kstep = (size_t)(BK * 2);
    const size_t hstep = (size_t)HALF * K * 2;
    const size_t tstep = 2 * hstep;
    const unsigned ldsw = (unsigned)wid * 1024u;
    const int aoff = lds_byte(wr * 64 + fr, fq * 8), boff = lds_byte(wc * 32 + fr, fq * 8);
#define PG8_SA(b, h) (((b) * 2 + (h)) * HTB)
#define PG8_SB(b, h) ((4 + (b) * 2 + (h)) * HTB)
#define PG8_STAGE(bufoff, gbase, voff) do { _Pragma("unroll") for (int _i = 0; _i < 2; ++_i) \
        __builtin_amdgcn_global_load_lds((const unsigned*)((const char*)(gbase) + (voff)[_i]), (PG8_LAS unsigned*)(lds + (bufoff) + ldsw + _i * 8192), 16, 0, 0); } while (0)
#define PG8_LDA(dst, b, h) do { _Pragma("unroll") for (int m = 0; m < 4; ++m) _Pragma("unroll") for (int k = 0; k < 2; ++k) dst[m][k] = *(const PG8_LAS bf16x8*)(lds + PG8_SA(b, h) + aoff + m * 2048 + k * 1024); } while (0)
#define PG8_LDB(dst, b, h) do { _Pragma("unroll") for (int n = 0; n < 2; ++n) _Pragma("unroll") for (int k = 0; k < 2; ++k) dst[n][k] = *(const PG8_LAS bf16x8*)(lds + PG8_SB(b, h) + boff + n * 2048 + k * 1024); } while (0)
#define PG8_MMA(ai, bj, At, Bt) do { __builtin_amdgcn_s_setprio(1); _Pragma("unroll") for (int m = 0; m < 4; ++m) _Pragma("unroll") for (int n = 0; n < 2; ++n) _Pragma("unroll") for (int k = 0; k < 2; ++k) \
        acc[ai][bj][m][n] = __builtin_amdgcn_mfma_f32_16x16x32_bf16(Bt[n][k], At[m][k], acc[ai][bj][m][n], 0, 0, 0); __builtin_amdgcn_s_setprio(0); } while (0)
#define PG8_WAIT_V(n) asm volatile("s_waitcnt vmcnt(" #n ")" ::: "memory")
#define PG8_WAIT_L(n) asm volatile("s_waitcnt lgkmcnt(" #n ")" ::: "memory")
#define PG8_BAR __builtin_amdgcn_s_barrier()
#define PG8_SCHED __builtin_amdgcn_sched_barrier(0)
    Unit cur, nxt; int ui = 0;
    if (!S.next(0, cur)) return;
    f32x4 acc[2][2][4][2];
#pragma unroll
    for (int a = 0; a < 2; ++a)
#pragma unroll
        for (int b = 0; b < 2; ++b)
#pragma unroll
            for (int m = 0; m < 4; ++m)
#pragma unroll
                for (int n = 0; n < 2; ++n) acc[a][b][m][n] = (f32x4){0.f, 0.f, 0.f, 0.f};
    bf16x8 At[4][2], B0[2][2], B1[2][2];
    const char* cA = (const char*)g.A + (size_t)cur.pm * tstep; const char* cB = (const char*)g.Bt + (size_t)cur.pn * tstep;
    S.a_ready(cur);
    if constexpr (SP2) {
        PG8_STAGE(PG8_SB(0, 0), cB, voffB); PG8_STAGE(PG8_SB(0, 1), cB + hstep, voffB); PG8_STAGE(PG8_SA(0, 0), cA, voffA); PG8_STAGE(PG8_SA(0, 1), cA + hstep, voffA);
        if (wr == 1) PG8_BAR;
        PG8_WAIT_V(2); PG8_BAR;
        PG8_STAGE(PG8_SB(1, 0), cB + kstep, voffB); PG8_STAGE(PG8_SA(1, 0), cA + kstep, voffA); PG8_STAGE(PG8_SB(1, 1), cB + hstep + kstep, voffB);
        PG8_WAIT_V(6); PG8_BAR;
    } else {
        PG8_STAGE(PG8_SB(0, 0), cB, voffB); PG8_STAGE(PG8_SA(0, 0), cA, voffA); PG8_STAGE(PG8_SB(0, 1), cB + hstep, voffB); PG8_STAGE(PG8_SA(0, 1), cA + hstep, voffA);
        if (wr == 1) PG8_BAR;
        PG8_WAIT_V(4); PG8_BAR;
        PG8_STAGE(PG8_SB(1, 0), cB + kstep, voffB); PG8_STAGE(PG8_SA(1, 0), cA + kstep, voffA); PG8_STAGE(PG8_SB(1, 1), cB + hstep + kstep, voffB);
        PG8_WAIT_V(6); PG8_BAR;
    }
    for (;;) {
        const bool has_next = S.next(ui + 1, nxt);
        const char* nA = has_next ? (const char*)g.A + (size_t)nxt.pm * tstep : cA; const char* nB = has_next ? (const char*)g.Bt + (size_t)nxt.pn * tstep : cB;
        for (int t = 0; t < nt; t += 2) {
            const bool last = (t == nt - 2);
            const char* a1 = cA + (size_t)(t + 1) * kstep;
            const char* a2 = last ? nA : cA + (size_t)(t + 2) * kstep; const char* b2 = last ? nB : cB + (size_t)(t + 2) * kstep;
            const char* a3 = a2 + kstep; const char* b3 = b2 + kstep;
            if (last && has_next) S.a_ready(nxt);
            if constexpr (SP2) {
            PG8_LDB(B0, 0, 0); PG8_LDB(B1, 0, 1); PG8_SCHED; PG8_LDA(At, 0, 0); PG8_STAGE(PG8_SA(1, 1), a1 + hstep, voffA);
            PG8_WAIT_V(8); PG8_WAIT_L(0); PG8_BAR; PG8_MMA(0, 0, At, B0); PG8_MMA(0, 1, At, B1); PG8_BAR; PG8_SCHED;
            PG8_LDA(At, 0, 1); PG8_STAGE(PG8_SB(0, 0), b2, voffB); PG8_STAGE(PG8_SB(0, 1), b2 + hstep, voffB); PG8_STAGE(PG8_SA(0, 0), a2, voffA);
            PG8_WAIT_V(8); PG8_WAIT_L(0); PG8_BAR; PG8_MMA(1, 0, At, B0); PG8_MMA(1, 1, At, B1); PG8_BAR; PG8_SCHED;
            PG8_LDB(B0, 1, 0); PG8_LDB(B1, 1, 1); PG8_SCHED; PG8_LDA(At, 1, 0); PG8_STAGE(PG8_SA(0, 1), a2 + hstep, voffA);
            PG8_WAIT_V(8); PG8_WAIT_L(0); PG8_BAR; PG8_MMA(0, 0, At, B0); PG8_MMA(0, 1, At, B1); PG8_BAR; PG8_SCHED;
            PG8_LDA(At, 1, 1); PG8_STAGE(PG8_SB(1, 0), b3, voffB); PG8_STAGE(PG8_SB(1, 1), b3 + hstep, voffB); PG8_STAGE(PG8_SA(1, 0), a3, voffA);
            PG8_WAIT_V(8); PG8_WAIT_L(0); PG8_BAR; PG8_MMA(1, 0, At, B0); PG8_MMA(1, 1, At, B1); PG8_BAR; PG8_SCHED;
            } else {
            PG8_LDB(B0, 0, 0); PG8_SCHED; PG8_LDA(At, 0, 0); PG8_STAGE(PG8_SA(1, 1), a1 + hstep, voffA);
            PG8_WAIT_L(8); PG8_BAR; PG8_WAIT_L(0); PG8_MMA(0, 0, At, B0); PG8_BAR; PG8_SCHED;
            PG8_LDB(B1, 0, 1); PG8_STAGE(PG8_SB(0, 0), b2, voffB);
            PG8_BAR; PG8_WAIT_L(0); PG8_MMA(0, 1, At, B1); PG8_BAR;
            PG8_LDA(At, 0, 1); PG8_STAGE(PG8_SA(0, 0), a2, voffA);
            PG8_BAR; PG8_WAIT_L(0); PG8_MMA(1, 0, At, B0); PG8_BAR; PG8_SCHED;
            PG8_STAGE(PG8_SB(0, 1), b2 + hstep, voffB);
            PG8_WAIT_V(6); PG8_BAR; PG8_MMA(1, 1, At, B1); PG8_BAR;
            PG8_LDB(B0, 1, 0); PG8_SCHED; PG8_LDA(At, 1, 0); PG8_STAGE(PG8_SA(0, 1), a2 + hstep, voffA);
            PG8_WAIT_L(8); PG8_BAR; PG8_WAIT_L(0); PG8_MMA(0, 0, At, B0); PG8_BAR; PG8_SCHED;
            PG8_LDB(B1, 1, 1); PG8_STAGE(PG8_SB(1, 0), b3, voffB);
            PG8_BAR; PG8_WAIT_L(0); PG8_MMA(0, 1, At, B1); PG8_BAR;
            PG8_LDA(At, 1, 1); PG8_STAGE(PG8_SA(1, 0), a3, voffA);
            PG8_BAR; PG8_WAIT_L(0); PG8_MMA(1, 0, At, B0); PG8_BAR; PG8_SCHED;
            PG8_STAGE(PG8_SB(1, 1), b3 + hstep, voffB);
            PG8_WAIT_V(6); PG8_BAR; PG8_MMA(1, 1, At, B1); PG8_BAR;
            }
        }
        if constexpr (ALIGN_EPI) { if (wr == 0) PG8_BAR; }
        if constexpr (!Epi::AFTER_DRAIN) { E(acc, cur, wr, wc, fr, fq); S.done(cur); }
        if (!has_next) break;
#pragma unroll
        for (int a = 0; a < 2; ++a)
#pragma unroll
            for (int b = 0; b < 2; ++b)
#pragma unroll
                for (int m = 0; m < 4; ++m)
#pragma unroll
                    for (int n = 0; n < 2; ++n) acc[a][b][m][n] = (f32x4){0.f, 0.f, 0.f, 0.f};
        cur = nxt; cA = nA; cB = nB; ++ui;
        if constexpr (ALIGN_EPI) { if (wr == 1) PG8_BAR; }
    }
    PG8_WAIT_V(0);
    if constexpr (!ALIGN_EPI) { if (wr == 0) PG8_BAR; }
    PG8_BAR;
    if constexpr (Epi::AFTER_DRAIN) { E.fused(acc, cur, wr, wc, fr, fq, lds, wid, lane); S.done(cur); }
#undef PG8_SA
#undef PG8_SB
#undef PG8_STAGE
#undef PG8_LDA
#undef PG8_LDB
#undef PG8_MMA
#undef PG8_WAIT_V
#undef PG8_WAIT_L
#undef PG8_BAR
#undef PG8_SCHED
}
}
#ifndef MK_SPLIT
#define MK_SPLIT 0
#endif
namespace mk {
#define LAS __attribute__((address_space(3)))
typedef unsigned short bf16_t;
typedef short bf16x8 __attribute__((ext_vector_type(8)));
typedef short s16x4 __attribute__((ext_vector_type(4)));
typedef float f32x4 __attribute__((ext_vector_type(4)));
typedef float f32x2 __attribute__((ext_vector_type(2)));
typedef float f32x16 __attribute__((ext_vector_type(16)));
typedef unsigned u32x4 __attribute__((ext_vector_type(4)));
typedef unsigned u32x2 __attribute__((ext_vector_type(2)));
using pg8::Unit;

constexpr int BATCH = 4, SEQ = 8192, DM = 1024, T = BATCH * SEQ, NH = 8;
constexpr int D_IN = 2464, N_IN = 2560;
constexpr float EPS = 1e-5f;
constexpr float DN_ALPHA = 1.189207115002721f;
constexpr float QSCALE = 0.10206207261596575f * 1.4426950408889634f;
constexpr int NWAVES = 8, NTHREADS = 512;

constexpr size_t MiB = 1u << 20;
constexpr size_t WS_WIN = 2 * MiB, WS_WUQ = 8 * MiB, WS_WUKV = 9 * MiB, WS_WOUT = 10 * MiB, WS_WSP = 12 * MiB;
constexpr size_t WS_SSQQ = 13 * MiB, WS_SSQKV = 13 * MiB + 512 * 1024, WS_VSTAT = 14 * MiB;
constexpr size_t WS_XB = 32 * MiB, WS_CQ = 96 * MiB, WS_CKV = 112 * MiB, WS_KR = 120 * MiB;
constexpr size_t WS_SZA = 128 * MiB, WS_GU = 160 * MiB, WS_GV = 192 * MiB, WS_SZB = 224 * MiB;
constexpr size_t WS_QN = 256 * MiB, WS_QR = 288 * MiB, WS_KN = 304 * MiB, WS_VV = 336 * MiB, WS_MG = 368 * MiB, WS_END = 432 * MiB;

constexpr int LDS_BYTES = 147456;

__device__ const float INVF[16] = {1.0f, 0.5623413324356079f, 0.3162277638912201f, 0.17782793939113617f, 0.10000000149011612f, 0.05623412877321243f,
    0.03162277862429619f, 0.017782794311642647f, 0.009999999776482582f, 0.005623413249850273f, 0.003162277862429619f, 0.0017782794311642647f,
    0.0010000000474974513f, 0.000562341301701963f, 0.0003162277862429619f, 0.00017782794020604342f};

__device__ __forceinline__ unsigned cvt2(float lo, float hi) { return pg8::cvt_pk_bf16(lo, hi); }
__device__ __forceinline__ u32x4 pack8(const f32x4 a, const f32x4 b) { u32x4 w; w.x = cvt2(a[0], a[1]); w.y = cvt2(a[2], a[3]); w.z = cvt2(b[0], b[1]); w.w = cvt2(b[2], b[3]); return w; }
__device__ __forceinline__ u32x2 pack4(const f32x4 a) { u32x2 w; w.x = cvt2(a[0], a[1]); w.y = cvt2(a[2], a[3]); return w; }
__device__ __forceinline__ float bf_lo(unsigned u) { return __uint_as_float(u << 16); }
__device__ __forceinline__ float bf_hi(unsigned u) { return __uint_as_float(u & 0xffff0000u); }
__device__ __forceinline__ f32x4 unpack4(const u32x2 w) { return (f32x4){bf_lo(w.x), bf_hi(w.x), bf_lo(w.y), bf_hi(w.y)}; }
__device__ __forceinline__ float silu_f(float x) { return x / (1.f + __expf(-x)); }
__device__ __forceinline__ f32x4 silu4(const f32x4 v) { return (f32x4){silu_f(v[0]), silu_f(v[1]), silu_f(v[2]), silu_f(v[3])}; }
__device__ __forceinline__ f32x4 gelu4(const f32x4 v) { const f32x2 a = pg8::gelu_pk((f32x2){v[0], v[1]}), b = pg8::gelu_pk((f32x2){v[2], v[3]}); return (f32x4){a.x, a.y, b.x, b.y}; }
__device__ __forceinline__ float sum4(const f32x4 v) { return (v[0] + v[1]) + (v[2] + v[3]); }
__device__ __forceinline__ float ssq4(const f32x4 v) { return (v[0] * v[0] + v[1] * v[1]) + (v[2] * v[2] + v[3] * v[3]); }
__device__ __forceinline__ float quad_sum(float s) { s += __shfl_xor(s, 16); s += __shfl_xor(s, 32); return s; }
__device__ __forceinline__ float wave_sum(float v) {
#pragma unroll
    for (int o = 1; o < 64; o <<= 1) v += __shfl_xor(v, o);
    return v;
}
__device__ __forceinline__ void rope4(const f32x4 t1, const f32x4 t2, int pos, int fq, f32x4& o1, f32x4& o2) {
    const float pf = (float)pos;
#pragma unroll
    for (int e = 0; e < 4; ++e) {
        const float ang = pf * INVF[4 * fq + e];
        const double x = (double)ang * 0.15915494309189535;
        const float fr = (float)(x - __builtin_rint(x));
        const float s = __builtin_amdgcn_sinf(fr), c = __builtin_amdgcn_cosf(fr);
        o1[e] = t1[e] * c - t2[e] * s; o2[e] = t1[e] * s + t2[e] * c;
    }
}

struct EpiInProj {
    static constexpr bool PERM = true, AFTER_DRAIN = false;
    bf16_t *CQ, *CKV, *KR, *ACT; float *SSQQ, *SSQKV, *VSTAT; const int* pos;
    __device__ __forceinline__ void operator()(const f32x4 (&acc)[2][2][4][2], const Unit& u, int wr, int wc, int fr, int fq) const {
        asm volatile("" : "+v"(fr), "+v"(fq));
        const int pn = u.pn, row0 = u.pm * 256 + wr * 64 + fr, cw = wc * 32 + 8 * fq;
        if (pn == 0) {
#pragma unroll
            for (int ai = 0; ai < 2; ++ai)
#pragma unroll
                for (int m = 0; m < 4; ++m) { const size_t row = row0 + ai * 128 + m * 16; float ss = 0.f;
#pragma unroll
                    for (int bj = 0; bj < 2; ++bj) { const f32x4 v0 = acc[ai][bj][m][0], v1 = acc[ai][bj][m][1]; ss += ssq4(v0) + ssq4(v1);
                        *(u32x4*)(CQ + row * 256 + bj * 128 + cw) = pack8(v0, v1); }
                    ss = quad_sum(ss); if (fq == 0) SSQQ[row * 4 + wc] = ss; }
        } else if (pn == 1) {
#pragma unroll
            for (int ai = 0; ai < 2; ++ai)
#pragma unroll
                for (int m = 0; m < 4; ++m) { const size_t row = row0 + ai * 128 + m * 16;
                    const f32x4 v0 = acc[ai][0][m][0], v1 = acc[ai][0][m][1]; float ss = ssq4(v0) + ssq4(v1);
                    *(u32x4*)(CKV + row * 128 + cw) = pack8(v0, v1);
                    ss = quad_sum(ss); if (fq == 0) SSQKV[row * 4 + wc] = ss;
                    if (wc == 0) { f32x4 o1, o2; rope4(acc[ai][1][m][0], acc[ai][1][m][1], pos[row], fq, o1, o2);
                        *(u32x2*)(KR + row * 32 + 4 * fq) = pack4(o1); *(u32x2*)(KR + row * 32 + 16 + 4 * fq) = pack4(o2); } }
        } else {
            const int seg = (pn - 2) >> 1, half = (pn - 2) & 1;
            bf16_t* dst = ACT + (size_t)seg * (16u << 20);
            const bool is_gelu = (seg == 1 || seg == 2);
#pragma unroll
            for (int ai = 0; ai < 2; ++ai)
#pragma unroll
                for (int m = 0; m < 4; ++m) { const size_t row = row0 + ai * 128 + m * 16; float s1 = 0.f, s2 = 0.f;
#pragma unroll
                    for (int bj = 0; bj < 2; ++bj) { f32x4 v0 = acc[ai][bj][m][0], v1 = acc[ai][bj][m][1];
                        if (is_gelu) { v0 = gelu4(v0); v1 = gelu4(v1); } else { v0 = silu4(v0); v1 = silu4(v1); }
                        s1 += sum4(v0) + sum4(v1); s2 += ssq4(v0) + ssq4(v1);
                        *(u32x4*)(dst + row * 512 + half * 256 + bj * 128 + cw) = pack8(v0, v1); }
                    if (seg == 2) { s1 = quad_sum(s1); s2 = quad_sum(s2); if (fq == 0) *(f32x2*)(VSTAT + (row * 8 + half * 4 + wc) * 2) = (f32x2){s1, s2}; } }
        }
    }
};
struct EpiQUp {
    static constexpr bool PERM = true, AFTER_DRAIN = false;
    bf16_t *QN, *QR; const float* SSQQ; const int* pos;
    __device__ __forceinline__ void operator()(const f32x4 (&acc)[2][2][4][2], const Unit& u, int wr, int wc, int fr, int fq) const {
        asm volatile("" : "+v"(fr), "+v"(fq));
        const int pn = u.pn, row0 = u.pm * 256 + wr * 64 + fr, cw = wc * 32 + 8 * fq;
#pragma unroll
        for (int ai = 0; ai < 2; ++ai)
#pragma unroll
            for (int m = 0; m < 4; ++m) { const size_t row = row0 + ai * 128 + m * 16;
                const f32x4 sq = *(const f32x4*)(SSQQ + row * 4);
                const float sc = QSCALE / sqrtf(sum4(sq) * (1.f / 256.f) + EPS);
                if (pn < 2) {
#pragma unroll
                    for (int bj = 0; bj < 2; ++bj) *(u32x4*)(QN + row * 512 + pn * 256 + bj * 128 + cw) = pack8(acc[ai][bj][m][0] * sc, acc[ai][bj][m][1] * sc);
                } else { const int p = pos[row];
#pragma unroll
                    for (int bj = 0; bj < 2; ++bj) { const int head = bj * 4 + wc; f32x4 o1, o2; rope4(acc[ai][bj][m][0] * sc, acc[ai][bj][m][1] * sc, p, fq, o1, o2);
                        *(u32x2*)(QR + row * 256 + head * 32 + 4 * fq) = pack4(o1); *(u32x2*)(QR + row * 256 + head * 32 + 16 + 4 * fq) = pack4(o2); asm volatile("" ::: "memory"); } }
                asm volatile("" ::: "memory");
            }
    }
};
struct EpiKVUp {
    static constexpr bool PERM = true, AFTER_DRAIN = false;
    bf16_t *KN; const float* SSQKV;
    __device__ __forceinline__ void operator()(const f32x4 (&acc)[2][2][4][2], const Unit& u, int wr, int wc, int fr, int fq) const {
        asm volatile("" : "+v"(fr), "+v"(fq));
        const int pn = u.pn, row0 = u.pm * 256 + wr * 64 + fr, cw = wc * 32 + 8 * fq;
        bf16_t* dst = KN + (size_t)(pn >> 1) * (16u << 20) + (pn & 1) * 256;
#pragma unroll
        for (int ai = 0; ai < 2; ++ai)
#pragma unroll
            for (int m = 0; m < 4; ++m) { const size_t row = row0 + ai * 128 + m * 16;
                const f32x4 sq = *(const f32x4*)(SSQKV + row * 4);
                const float sc = 1.f / sqrtf(sum4(sq) * (1.f / 128.f) + EPS);
#pragma unroll
                for (int bj = 0; bj < 2; ++bj) *(u32x4*)(dst + row * 512 + bj * 128 + cw) = pack8(acc[ai][bj][m][0] * sc, acc[ai][bj][m][1] * sc); }
    }
};
struct EpiOut {
    static constexpr bool PERM = true, AFTER_DRAIN = false;
    const float* x; float* out;
    __device__ __forceinline__ void operator()(const f32x4 (&acc)[2][2][4][2], const Unit& u, int wr, int wc, int fr, int fq) const {
        asm volatile("" : "+v"(fr), "+v"(fq));
        const int row0 = u.pm * 256 + wr * 64 + fr, col0 = u.pn * 256 + wc * 32 + 8 * fq;
#pragma unroll
        for (int ai = 0; ai < 2; ++ai)
#pragma unroll
            for (int m = 0; m < 4; ++m) { const size_t off = (size_t)(row0 + ai * 128 + m * 16) * DM + col0;
#pragma unroll
                for (int bj = 0; bj < 2; ++bj) { const f32x4 x0 = *(const f32x4*)(x + off + bj * 128), x1 = *(const f32x4*)(x + off + bj * 128 + 4);
                    *(f32x4*)(out + off + bj * 128) = x0 * DN_ALPHA + acc[ai][bj][m][0]; *(f32x4*)(out + off + bj * 128 + 4) = x1 * DN_ALPHA + acc[ai][bj][m][1]; } }
    }
};

__device__ __forceinline__ int rope_perm(int pp) { const int fq = pp >> 3, j = pp & 7; return (j < 4) ? 4 * fq + j : 16 + 4 * fq + (j - 4); }
__device__ __forceinline__ int src_col(int kind, int n) {
    if (kind == 0) {
        if (n < 384) return n; if (n < 416) return 384 + rope_perm(n - 384); if (n < 512) return -1; return n - 96;
    } else if (kind == 1) {
        if (n < 512) return (n >> 6) * 96 + (n & 63); const int p = n - 512; return (p >> 5) * 96 + 64 + rope_perm(p & 31);
    } else if (kind == 2) {
        if (n < 512) return (n >> 6) * 128 + (n & 63); const int p = n - 512; return (p >> 6) * 128 + 64 + (p & 63);
    }
    return n;
}
__device__ __forceinline__ void transpose_item(const float* W, int K, int Nsrc, int Ndst, bf16_t* WT, int kind, const float* kscale, LAS float* scr, int item, int lane) {
    const int nblk = Ndst / 32, kb = item / nblk, nb = item % nblk, k0 = 64 * kb, n0 = 32 * nb;
    const int sc = src_col(kind, n0 + (lane & 31));
#pragma unroll 8
    for (int i = 0; i < 32; ++i) { const int kk = 2 * i + (lane >> 5); float v = 0.f;
        if (sc >= 0) { v = W[(size_t)(k0 + kk) * Nsrc + sc]; if (kscale) v *= kscale[k0 + kk]; }
        scr[kk * 33 + (lane & 31)] = v; }
    asm volatile("s_waitcnt lgkmcnt(0)" ::: "memory");
    const int c = lane & 7;
#pragma unroll
    for (int j = 0; j < 4; ++j) { const int n = (lane >> 3) + 8 * j; const LAS float* s = scr + (8 * c) * 33 + n;
        u32x4 o; o.x = cvt2(s[0 * 33], s[1 * 33]); o.y = cvt2(s[2 * 33], s[3 * 33]); o.z = cvt2(s[4 * 33], s[5 * 33]); o.w = cvt2(s[6 * 33], s[7 * 33]);
        *(u32x4*)(WT + (size_t)(n0 + n) * K + k0 + 8 * c) = o; }
    asm volatile("s_waitcnt lgkmcnt(0)" ::: "memory");
}

__device__ __forceinline__ int crow(int r, int hi) { return (r & 3) + 8 * (r >> 2) + 4 * hi; }
__device__ __forceinline__ s16x4 vtr(const LAS unsigned char* p) { typedef short v4i16_t __attribute__((ext_vector_type(4)));
    return __builtin_bit_cast(s16x4, __builtin_amdgcn_ds_read_tr16_b64_v4i16((LAS v4i16_t*)p)); }
constexpr int ATT_KSLOT = 12288, ATT_VSLOT = 8192, ATT_VOFF = 2 * ATT_KSLOT;
struct AttT { const bf16_t *QN, *QR, *KN, *KR, *VV, *SZA; bf16_t* MG; };

__device__ __forceinline__ void attn_unit(int b, int h, int qb, const AttT& A, LAS unsigned char* lds) {
    int tid_ = threadIdx.x; asm volatile("" : "+v"(tid_));
    const int tid = tid_, lane = tid & 63, r32 = lane & 31, hi = lane >> 5;
    const int wid = __builtin_amdgcn_readfirstlane(tid >> 6);
    const size_t rowbase = (size_t)b * SEQ; const int q0 = qb * 256;
    const size_t qrow = rowbase + q0 + wid * 32 + r32;
    bf16x8 qf[6];
#pragma unroll
    for (int d0 = 0; d0 < 4; ++d0) qf[d0] = *(const bf16x8*)(A.QN + qrow * 512 + h * 64 + d0 * 16 + hi * 8);
#pragma unroll
    for (int d0 = 0; d0 < 2; ++d0) qf[4 + d0] = *(const bf16x8*)(A.QR + qrow * 256 + h * 32 + d0 * 16 + hi * 8);
    const int NT = (q0 + 256) / 64, tl = (q0 + wid * 32) >> 6;
    const bf16_t* kn_src = A.KN + (rowbase + lane) * 512 + h * 64 + wid * 8;
    const bf16_t* kr_src = A.KR + (rowbase + lane) * 32 + (wid & 3) * 8;
    const bf16_t* v_src = A.VV + (rowbase + (wid & 3) * 16 + (lane >> 2)) * 512 + h * 64 + (wid >> 2) * 32 + (lane & 3) * 8;
    const int kn_dst = wid * 1024 + lane * 16, kr_dst = (8 + (wid & 3)) * 1024 + lane * 16, v_dst = ATT_VOFF + wid * 1024 + lane * 16;
    u32x4 rk0, rk1 = (u32x4){0u, 0u, 0u, 0u}, rv;
#define ATT_LOAD(t) do { rk0 = *(const u32x4*)(kn_src + (size_t)(t) * 64 * 512); if (wid < 4) rk1 = *(const u32x4*)(kr_src + (size_t)(t) * 64 * 32); rv = *(const u32x4*)(v_src + (size_t)(t) * 64 * 512); } while (0)
#define ATT_STORE(buf) do { *(LAS u32x4*)(lds + (buf) * ATT_KSLOT + kn_dst) = rk0; if (wid < 4) *(LAS u32x4*)(lds + (buf) * ATT_KSLOT + kr_dst) = rk1; *(LAS u32x4*)(lds + (buf) * ATT_VSLOT + v_dst) = rv; } while (0)
    ATT_LOAD(0); ATT_STORE(0);
    __syncthreads();
    float m_run = -INFINITY, l_run = 0.f;
    f32x16 o0, o1;
#pragma unroll
    for (int r = 0; r < 16; ++r) { o0[r] = 0.f; o1[r] = 0.f; }
    const int kfb = hi * 1024 + r32 * 16;
    const int vfb = ATT_VOFF + (4 * hi + ((lane & 15) >> 2)) * 64 + ((lane >> 4) & 1) * 32 + (lane & 3) * 8;
    for (int t = 0; t < NT; ++t) {
        const int cur = t & 1;
        if (t + 1 < NT) ATT_LOAD(t + 1);
        if (t <= tl) {
            const LAS unsigned char* kb = lds + cur * ATT_KSLOT + kfb;
            f32x16 p0, p1;
#pragma unroll
            for (int r = 0; r < 16; ++r) { p0[r] = 0.f; p1[r] = 0.f; }
#pragma unroll
            for (int d0 = 0; d0 < 6; ++d0) {
                const bf16x8 k0 = *(const LAS bf16x8*)(kb + d0 * 2048), k1 = *(const LAS bf16x8*)(kb + d0 * 2048 + 512);
                p0 = __builtin_amdgcn_mfma_f32_32x32x16_bf16(k0, qf[d0], p0, 0, 0, 0);
                p1 = __builtin_amdgcn_mfma_f32_32x32x16_bf16(k1, qf[d0], p1, 0, 0, 0);
            }
            if (t == tl) {
                const int qrel = q0 + wid * 32 + r32 - 64 * t;
#pragma unroll
                for (int r = 0; r < 16; ++r) { const int kv = crow(r, hi); if (kv > qrel) p0[r] = -INFINITY; if (kv + 32 > qrel) p1[r] = -INFINITY; }
            }
            float mx = fmaxf(p0[0], p1[0]);
#pragma unroll
            for (int r = 1; r < 16; ++r) mx = fmaxf(mx, fmaxf(p0[r], p1[r]));
            mx = fmaxf(mx, __shfl_xor(mx, 32));
            const float m_new = fmaxf(m_run, mx);
            const float alpha = __builtin_amdgcn_exp2f(m_run - m_new);
            float ls = 0.f;
#pragma unroll
            for (int r = 0; r < 16; ++r) { p0[r] = __builtin_amdgcn_exp2f(p0[r] - m_new); p1[r] = __builtin_amdgcn_exp2f(p1[r] - m_new); ls += p0[r] + p1[r]; }
            l_run = l_run * alpha + ls; m_run = m_new;
            if (__any(alpha != 1.f)) {
#pragma unroll
                for (int r = 0; r < 16; ++r) { o0[r] *= alpha; o1[r] *= alpha; }
            }
            bf16x8 pf[4];
            { u32x4 w;
              w.x = cvt2(p0[0], p0[1]); w.y = cvt2(p0[2], p0[3]); w.z = cvt2(p0[4], p0[5]); w.w = cvt2(p0[6], p0[7]); pf[0] = __builtin_bit_cast(bf16x8, w);
              w.x = cvt2(p0[8], p0[9]); w.y = cvt2(p0[10], p0[11]); w.z = cvt2(p0[12], p0[13]); w.w = cvt2(p0[14], p0[15]); pf[1] = __builtin_bit_cast(bf16x8, w);
              w.x = cvt2(p1[0], p1[1]); w.y = cvt2(p1[2], p1[3]); w.z = cvt2(p1[4], p1[5]); w.w = cvt2(p1[6], p1[7]); pf[2] = __builtin_bit_cast(bf16x8, w);
              w.x = cvt2(p1[8], p1[9]); w.y = cvt2(p1[10], p1[11]); w.z = cvt2(p1[12], p1[13]); w.w = cvt2(p1[14], p1[15]); pf[3] = __builtin_bit_cast(bf16x8, w); }
            const LAS unsigned char* vb = lds + cur * ATT_VSLOT + vfb;
#pragma unroll
            for (int ks = 0; ks < 4; ++ks) {
                const s16x4 a0 = vtr(vb + ks * 1024), a1 = vtr(vb + ks * 1024 + 512), b0 = vtr(vb + 4096 + ks * 1024), b1 = vtr(vb + 4096 + ks * 1024 + 512);
                const bf16x8 va = (bf16x8){a0[0], a0[1], a0[2], a0[3], a1[0], a1[1], a1[2], a1[3]}, vbq = (bf16x8){b0[0], b0[1], b0[2], b0[3], b1[0], b1[1], b1[2], b1[3]};
                o0 = __builtin_amdgcn_mfma_f32_32x32x16_bf16(va, pf[ks], o0, 0, 0, 0);
                o1 = __builtin_amdgcn_mfma_f32_32x32x16_bf16(vbq, pf[ks], o1, 0, 0, 0);
            }
        }
        if (t + 1 < NT) ATT_STORE(cur ^ 1);
        __syncthreads();
    }
#undef ATT_LOAD
#undef ATT_STORE
    const float inv = 1.f / (l_run + __shfl_xor(l_run, 32));
    const bf16_t* zrow = A.SZA + qrow * 512 + h * 64; bf16_t* orow = A.MG + qrow * 1024 + h * 64;
#pragma unroll
    for (int j = 0; j < 4; ++j) { const int d = 8 * j + 4 * hi;
        const f32x4 z0 = unpack4(*(const u32x2*)(zrow + d)), z1 = unpack4(*(const u32x2*)(zrow + 32 + d));
        const f32x4 a = (f32x4){o0[4 * j], o0[4 * j + 1], o0[4 * j + 2], o0[4 * j + 3]} * inv * z0, c = (f32x4){o1[4 * j], o1[4 * j + 1], o1[4 * j + 2], o1[4 * j + 3]} * inv * z1;
        *(u32x2*)(orow + d) = pack4(a); *(u32x2*)(orow + 32 + d) = pack4(c); }
}

struct SguT { const bf16_t *GV, *GU, *SZB, *WSP; const float *VSTAT, *g, *bta, *bsp; bf16_t* MG; };
__device__ __forceinline__ void sgu_unit(int chunk, int h, const SguT& S, LAS unsigned char* lds) {
    int tid_ = threadIdx.x; asm volatile("" : "+v"(tid_));
    const int tid = tid_, lane = tid & 63, r32 = lane & 31, hi = lane >> 5;
    const int wid = __builtin_amdgcn_readfirstlane(tid >> 6);
    const size_t row0 = (size_t)chunk * 128;
    {
        const int s = tid >> 2, ch = tid & 3; const size_t row = row0 + s;
        const f32x4* st = (const f32x4*)(S.VSTAT + row * 16);
        const f32x4 a = st[0], b = st[1], c = st[2], d = st[3];
        const float s1 = (a[0] + a[2]) + (b[0] + b[2]) + (c[0] + c[2]) + (d[0] + d[2]), s2 = (a[1] + a[3]) + (b[1] + b[3]) + (c[1] + c[3]) + (d[1] + d[3]);
        const float mean = s1 * (1.f / 512.f), var = fmaxf(s2 * (1.f / 512.f) - mean * mean, 0.f), rstd = 1.f / sqrtf(var + EPS);
#pragma unroll
        for (int dh = 0; dh < 2; ++dh) { const int c0 = h * 64 + dh * 32 + ch * 8;
            const u32x4 raw = *(const u32x4*)(S.GV + row * 512 + c0);
            const f32x4 g0 = *(const f32x4*)(S.g + c0), g1 = *(const f32x4*)(S.g + c0 + 4), b0 = *(const f32x4*)(S.bta + c0), b1 = *(const f32x4*)(S.bta + c0 + 4);
            f32x4 v0 = (f32x4){bf_lo(raw.x), bf_hi(raw.x), bf_lo(raw.y), bf_hi(raw.y)}, v1 = (f32x4){bf_lo(raw.z), bf_hi(raw.z), bf_lo(raw.w), bf_hi(raw.w)};
            v0 = (v0 - mean) * rstd * g0 + b0; v1 = (v1 - mean) * rstd * g1 + b1;
            *(LAS u32x4*)(lds + dh * 8192 + s * 64 + ch * 16) = pack8(v0, v1); }
    }
    __syncthreads();
    const int db = wid & 1, tb = wid >> 1, t = 32 * tb + r32, nks = 2 * tb + 2;
    f32x16 acc;
#pragma unroll
    for (int r = 0; r < 16; ++r) acc[r] = 0.f;
    const LAS unsigned char* vb = lds + db * 8192 + (8 * hi + ((lane & 15) >> 2)) * 64 + ((lane >> 4) & 1) * 32 + (lane & 3) * 8;
    const bf16_t* wrow = S.WSP + ((size_t)h * 128 + t) * 128 + 8 * hi;
    for (int ks = 0; ks < nks; ++ks) {
        const s16x4 a0 = vtr(vb + ks * 1024), a1 = vtr(vb + ks * 1024 + 256);
        const bf16x8 va = (bf16x8){a0[0], a0[1], a0[2], a0[3], a1[0], a1[1], a1[2], a1[3]};
        const bf16x8 wf = *(const bf16x8*)(wrow + 16 * ks);
        acc = __builtin_amdgcn_mfma_f32_32x32x16_bf16(va, wf, acc, 0, 0, 0);
    }
    const float bias = S.bsp[h * 128 + t];
    const size_t row = row0 + t; const int cbase = h * 64 + 32 * db;
#pragma unroll
    for (int j = 0; j < 4; ++j) { const int c = cbase + 8 * j + 4 * hi;
        const f32x4 gu = unpack4(*(const u32x2*)(S.GU + row * 512 + c)), zb = unpack4(*(const u32x2*)(S.SZB + row * 512 + c));
        const f32x4 sv = (f32x4){acc[4 * j], acc[4 * j + 1], acc[4 * j + 2], acc[4 * j + 3]} + bias;
        *(u32x2*)(S.MG + row * 1024 + 512 + c) = pack4(sv * gu * zb); }
    __syncthreads();
}

struct Args { const float* in[14]; float* out; unsigned char* ws; int ph_lo, ph_hi; };
static_assert(WS_GU - WS_SZA == 32 * MiB && WS_GV - WS_GU == 32 * MiB && WS_SZB - WS_GV == 32 * MiB && WS_VV - WS_KN == 32 * MiB, "epilogue pointer arithmetic");
static_assert(sizeof(Args) == 14 * 8 + 8 + 8 + 8, "Args has no padding");

__global__ void __launch_bounds__(NTHREADS, 2) mk_fwd(Args args) {
    extern __shared__ __attribute__((aligned(16))) unsigned char lds_raw[];
    LAS unsigned char* lds = (LAS unsigned char*)lds_raw;
    const int G = gridDim.x, bx = blockIdx.x, vcu = (G % 8 == 0) ? (bx % 8) * (G / 8) + bx / 8 : bx;
    const int lo = args.ph_lo, hi = args.ph_hi;
    const float* x = args.in[0]; const int* pos = (const int*)args.in[1];
#define WSPTR(name, type, off) unsigned char* name##_b = args.ws; asm volatile("" : "+s"(name##_b)); type* name = (type*)(name##_b + (off))
#ifndef MK_PHASES
#define MK_PHASES 63
#endif
#define IN(k) (((MK_PHASES >> (k)) & 1) && lo <= (k) && (k) < hi)
#define SEAM(k) do { if (IN(k) && IN((k) + 1)) { cg::this_grid().sync(); } } while (0)

    if (IN(0)) {
        const float *w_in = args.in[2], *q_g = args.in[3], *w_uq = args.in[4], *kv_g = args.in[5], *w_ukv = args.in[6], *w_sp = args.in[9], *w_out = args.in[11];
        WSPTR(WIN, bf16_t, WS_WIN); bf16_t *WUQ = WIN + (WS_WUQ - WS_WIN) / 2, *WUKV = WIN + (WS_WUKV - WS_WIN) / 2, *WOUT = WIN + (WS_WOUT - WS_WIN) / 2, *WSP = WIN + (WS_WSP - WS_WIN) / 2, *XB = WIN + (WS_XB - WS_WIN) / 2;
        int tid = threadIdx.x; asm volatile("" : "+v"(tid)); const int lane = tid & 63, wave = __builtin_amdgcn_readfirstlane(tid >> 6);
        LAS float* scr = (LAS float*)(lds + wave * 16384);
        const int gw = vcu * NWAVES + wave, NGW = G * NWAVES;
        constexpr int I_IN = (DM / 64) * (N_IN / 32), I_UQ = (256 / 64) * (768 / 32), I_UKV = (128 / 64) * (1024 / 32), I_OUT = (DM / 64) * (DM / 32);
        for (int it = gw; it < I_IN + I_UQ + I_UKV + I_OUT; it += NGW) {
            int r = it;
            if (r < I_IN) { transpose_item(w_in, DM, D_IN, N_IN, WIN, 0, nullptr, scr, r, lane); continue; } r -= I_IN;
            if (r < I_UQ) { transpose_item(w_uq, 256, 768, 768, WUQ, 1, q_g, scr, r, lane); continue; } r -= I_UQ;
            if (r < I_UKV) { transpose_item(w_ukv, 128, 1024, 1024, WUKV, 2, kv_g, scr, r, lane); continue; } r -= I_UKV;
            transpose_item(w_out, DM, DM, DM, WOUT, 3, nullptr, scr, r, lane);
        }
        const int gt = vcu * NTHREADS + tid, NGT = G * NTHREADS;
        for (int i = gt; i < NH * 128 * 128 / 8; i += NGT) {
            const int e = i * 8, tt = (e >> 7) & 127, s0 = e & 127;
            const f32x4 a = *(const f32x4*)(w_sp + e), b = *(const f32x4*)(w_sp + e + 4); f32x4 a2, b2;
#pragma unroll
            for (int j = 0; j < 4; ++j) { a2[j] = (s0 + j <= tt) ? a[j] : 0.f; b2[j] = (s0 + 4 + j <= tt) ? b[j] : 0.f; }
            *(u32x4*)(WSP + e) = pack8(a2, b2);
        }
        for (int i = gt; i < T * DM / 8; i += NGT) {
            const f32x4 a = *(const f32x4*)(x + (size_t)i * 8), b = *(const f32x4*)(x + (size_t)i * 8 + 4);
            *(u32x4*)(XB + (size_t)i * 8) = pack8(a, b);
        }
    }
    SEAM(0);
    if (IN(1)) {
        WSPTR(WIN, bf16_t, WS_WIN); bf16_t *XB = WIN + (WS_XB - WS_WIN) / 2, *CQ = WIN + (WS_CQ - WS_WIN) / 2, *CKV = WIN + (WS_CKV - WS_WIN) / 2, *KR = WIN + (WS_KR - WS_WIN) / 2, *SZA = WIN + (WS_SZA - WS_WIN) / 2;
        float *SSQQ = (float*)(WIN + (WS_SSQQ - WS_WIN) / 2), *SSQKV = (float*)(WIN + (WS_SSQKV - WS_WIN) / 2), *VSTAT = (float*)(WIN + (WS_VSTAT - WS_WIN) / 2);
        pg8::Gemm g{XB, WIN, T, N_IN, DM}; pg8::StaticOrder S; S.init(T, N_IN, G, bx);
        EpiInProj E{CQ, CKV, KR, SZA, SSQQ, SSQKV, VSTAT, pos};
        pg8::gemm_phase<EpiInProj, pg8::StaticOrder, true, true>(lds, g, S, E);
    }
    SEAM(1);
    if (IN(2)) {
        WSPTR(WIN, bf16_t, WS_WIN); bf16_t *WUQ = WIN + (WS_WUQ - WS_WIN) / 2, *WUKV = WIN + (WS_WUKV - WS_WIN) / 2, *CQ = WIN + (WS_CQ - WS_WIN) / 2, *CKV = WIN + (WS_CKV - WS_WIN) / 2, *QN = WIN + (WS_QN - WS_WIN) / 2, *QR = WIN + (WS_QR - WS_WIN) / 2, *KN = WIN + (WS_KN - WS_WIN) / 2;
        float *SSQQ = (float*)(WIN + (WS_SSQQ - WS_WIN) / 2), *SSQKV = (float*)(WIN + (WS_SSQKV - WS_WIN) / 2);
        { pg8::Gemm g{CQ, WUQ, T, 768, 256}; pg8::StaticOrder S; S.init(T, 768, G, bx);
          EpiQUp E{QN, QR, SSQQ, pos};
          pg8::gemm_phase<EpiQUp, pg8::StaticOrder, true, true>(lds, g, S, E); }
        { pg8::Gemm g{CKV, WUKV, T, 1024, 128}; pg8::StaticOrder S; S.init(T, 1024, G, bx);
          EpiKVUp E{KN, SSQKV};
          pg8::gemm_phase<EpiKVUp, pg8::StaticOrder, true, true>(lds, g, S, E); }
    }
    SEAM(2);
    if (IN(3)) {
        const float *sgu_g = args.in[7], *sgu_b = args.in[8], *b_sp = args.in[10];
        WSPTR(WIN, bf16_t, WS_WIN); bf16_t *WSP = WIN + (WS_WSP - WS_WIN) / 2, *KR = WIN + (WS_KR - WS_WIN) / 2, *SZA = WIN + (WS_SZA - WS_WIN) / 2, *GU = WIN + (WS_GU - WS_WIN) / 2, *GV = WIN + (WS_GV - WS_WIN) / 2, *SZB = WIN + (WS_SZB - WS_WIN) / 2,
            *QN = WIN + (WS_QN - WS_WIN) / 2, *QR = WIN + (WS_QR - WS_WIN) / 2, *KN = WIN + (WS_KN - WS_WIN) / 2, *VV = WIN + (WS_VV - WS_WIN) / 2, *MG = WIN + (WS_MG - WS_WIN) / 2;
        float* VSTAT = (float*)(WIN + (WS_VSTAT - WS_WIN) / 2);
        const AttT A{QN, QR, KN, KR, VV, SZA, MG};
        for (int idx = vcu; idx < BATCH * NH * 32; idx += G) {
            const int i = idx >> 8, v = idx & 255, bh = v >> 3, s = v & 7;
            const int qb = (i == 0) ? s : (i == 1) ? 15 - s : (i == 2) ? 16 + s : 31 - s;
            attn_unit(bh >> 3, bh & 7, qb, A, lds);
        }
        const SguT Sg{GV, GU, SZB, WSP, VSTAT, sgu_g, sgu_b, b_sp, MG};
        for (int idx = vcu; idx < (T / 128) * NH; idx += G) sgu_unit(idx >> 3, idx & 7, Sg, lds);
    }
    SEAM(3);
    if (IN(4)) {
        WSPTR(WIN, bf16_t, WS_WIN); bf16_t *WOUT = WIN + (WS_WOUT - WS_WIN) / 2, *MG = WIN + (WS_MG - WS_WIN) / 2;
        pg8::Gemm g{MG, WOUT, T, DM, DM}; pg8::StaticOrder S; S.init(T, DM, G, bx);
        EpiOut E{x, args.out};
        pg8::gemm_phase<EpiOut, pg8::StaticOrder, true, true>(lds, g, S, E);
    }
    SEAM(4);
    if (IN(5)) {
        const float *ln_g = args.in[12], *ln_b = args.in[13];
        int tid = threadIdx.x; asm volatile("" : "+v"(tid)); const int lane = tid & 63, wave = __builtin_amdgcn_readfirstlane(tid >> 6);
        const int gw = vcu * NWAVES + wave, NGW = G * NWAVES;
        f32x4 gg[4], bb[4];
#pragma unroll
        for (int j = 0; j < 4; ++j) { gg[j] = *(const f32x4*)(ln_g + 4 * lane + 256 * j); bb[j] = *(const f32x4*)(ln_b + 4 * lane + 256 * j); }
        for (int m = gw; m < T; m += NGW) {
            f32x4* rowp = (f32x4*)(args.out + (size_t)m * DM) + lane;
            f32x4 v[4]; float s = 0.f;
#pragma unroll
            for (int j = 0; j < 4; ++j) { v[j] = rowp[64 * j]; s += sum4(v[j]); }
            const float mean = wave_sum(s) * (1.f / DM); float s2 = 0.f;
#pragma unroll
            for (int j = 0; j < 4; ++j) { v[j] = v[j] - mean; s2 += ssq4(v[j]); }
            const float rstd = 1.f / sqrtf(wave_sum(s2) * (1.f / DM) + EPS);
#pragma unroll
            for (int j = 0; j < 4; ++j) rowp[64 * j] = v[j] * rstd * gg[j] + bb[j];
        }
    }
#undef IN
#undef SEAM
}
}

extern "C" void kernel_launch(void* const* d_in, const int* in_sizes, int n_in, void* d_out, int out_size, void* d_ws, size_t ws_size, hipStream_t stream) {
    using namespace mk;
    static int grid = 0;
    if (grid == 0) {
        if (n_in != 14 || in_sizes[0] != T * DM || out_size != T * DM || ws_size < WS_END) {
            fprintf(stderr, "kernel_launch: unexpected problem (n_in %d, in0 %d, out %d, ws %zu)\n", n_in, n_in > 0 ? in_sizes[0] : -1, out_size, ws_size); grid = -1; return; }
        int dev = 0, cus = 0, per_cu = 0;
        if (hipGetDevice(&dev) != hipSuccess || hipDeviceGetAttribute(&cus, hipDeviceAttributeMultiprocessorCount, dev) != hipSuccess) { grid = -1; return; }
        if (hipFuncSetAttribute((const void*)mk_fwd, hipFuncAttributeMaxDynamicSharedMemorySize, LDS_BYTES) != hipSuccess) { fprintf(stderr, "kernel_launch: hipFuncSetAttribute failed\n"); grid = -1; return; }
        if (hipOccupancyMaxActiveBlocksPerMultiprocessor(&per_cu, (const void*)mk_fwd, NTHREADS, LDS_BYTES) != hipSuccess || per_cu < 1) {
            fprintf(stderr, "kernel_launch: occupancy query reports %d workgroups per CU\n", per_cu); (void)hipGetLastError(); grid = -1; return; }
        grid = cus;
    }
    if (grid < 0) return;
    Args a{};
    for (int i = 0; i < 14; ++i) a.in[i] = (const float*)d_in[i];
    a.out = (float*)d_out; a.ws = (unsigned char*)d_ws;
#if MK_SPLIT
    for (int p = 0; p < 6; ++p) { a.ph_lo = p; a.ph_hi = p + 1; hipLaunchKernelGGL(mk_fwd, dim3(grid), dim3(NTHREADS), LDS_BYTES, stream, a); }
#else
    a.ph_lo = 0; a.ph_hi = 6;
    void* kargs[] = {&a};
    const hipError_t e = hipLaunchCooperativeKernel((const void*)mk_fwd, dim3(grid), dim3(NTHREADS), kargs, LDS_BYTES, stream);
    if (e != hipSuccess) fprintf(stderr, "kernel_launch: cooperative launch failed: %s (grid %d)\n", hipGetErrorString(e), grid);
#endif
}
```

```cpp
#include <hip/hip_runtime.h>
#include <hip/hip_cooperative_groups.h>
#include <cstdio>
#include <cstdint>
namespace cg = cooperative_groups;
namespace pg8 {
#define PG8_LAS __attribute__((address_space(3)))
typedef unsigned short bf16_t;
typedef short bf16x8 __attribute__((ext_vector_type(8)));
typedef float f32x4 __attribute__((ext_vector_type(4)));
typedef unsigned u32x4 __attribute__((ext_vector_type(4)));
constexpr int BM = 256, BK = 64, HALF = 128, HTB = HALF * BK * 2  , STAGE_BYTES = 8 * HTB, NXCD = 8, WGM = 8;

__host__ __device__ __forceinline__ int lds_byte(int r, int c) { const int st = (r >> 4) * 2 + (c >> 5), rr = r & 15, cc = c & 31, ob = rr * 64 + cc * 2; return st * 1024 + (ob ^ (((ob >> 9) & 1) << 5)); }
__host__ __device__ __forceinline__ void stage_rc(int b, int& R, int& C) { const int st = b / 1024, sb = b % 1024, swz = sb ^ (((sb >> 9) & 1) << 5); R = (st >> 1) * 16 + swz / 64; C = (st & 1) * 32 + (swz % 64) / 2; }
__host__ __device__ __forceinline__ int perm32(int rho) { const int n = rho >> 4, i = rho & 15; return 8 * (i >> 2) + 4 * n + (i & 3); }

struct Unit { int pm, pn; };
struct Gemm { const bf16_t* A; const bf16_t* Bt; int M, N, K; };

struct StaticOrder {
    int nM, nN, nwg, G, c;
    __host__ __device__ void init(int M, int N, int G_, int c_) { nM = M / BM; nN = N / BM; nwg = nM * nN; G = G_; c = c_; }
    __host__ __device__ bool next(int i, Unit& u) const {
        const long L = (long)i * G + c; if (L >= nwg) return false;
        int wgid = (int)L; { const int q = nwg / NXCD, r = nwg % NXCD, xcd = wgid % NXCD, off = wgid / NXCD; wgid = (xcd < r ? xcd * (q + 1) : r * (q + 1) + (xcd - r) * q) + off; }
        const int nig = WGM * nN, gid = wgid / nig, fm = gid * WGM, gsz = (nM - fm) < WGM ? (nM - fm) : WGM;
        u.pm = fm + ((wgid % nig) % gsz); u.pn = (wgid % nig) / gsz; return true;
    }
    __device__ __forceinline__ void a_ready(const Unit&) const {}
    __device__ __forceinline__ void done(const Unit&) const {}
};

__device__ __forceinline__ unsigned cvt_pk_bf16(float lo, float hi) { unsigned r; asm volatile("v_cvt_pk_bf16_f32 %0, %1, %2" : "=v"(r) : "v"(lo), "v"(hi)); return r; }
typedef float f32x2 __attribute__((ext_vector_type(2)));
__device__ __forceinline__ f32x2 gelu_pk(f32x2 v) {
    const f32x2 av = __builtin_elementwise_abs(v), d = av * 0.2316418882f + 1.0f;
    f32x2 t; t.x = __builtin_amdgcn_rcpf(d.x); t.y = __builtin_amdgcn_rcpf(d.y);
    f32x2 q = t * 0.5307027145f + (-0.7265760135f); q = q * t + 0.7107068705f; q = q * t + (-0.142248368f); q = q * t + 0.127414796f; q = q * t;
    const f32x2 s = (v * v) * (-0.72134752044f);
    f32x2 e; e.x = __builtin_amdgcn_exp2f(s.x); e.y = __builtin_amdgcn_exp2f(s.y);
    const f32x2 m = v * (q * e), r = v - m;
    f32x2 o; o.x = v.x < 0.f ? m.x : r.x; o.y = v.y < 0.f ? m.y : r.y; return o;
}

template <int ACT  > struct EpiBf16 {
    static constexpr bool PERM = true, AFTER_DRAIN = false; static_assert(ACT == 0 || ACT == 1, "EpiBf16: ACT is 0 (none) or 1 (gelu_pk)");
    bf16_t* O; int ldc; const float* bias; int split_cols; size_t split_stride; float scale0;
    __device__ __forceinline__ void operator()(const f32x4 (&acc)[2][2][4][2], const Unit& u, int wr, int wc, int fr, int fq) const {
        const int row0 = u.pm * BM + wr * 64 + fr; int colt = u.pn * BM; bf16_t* base = O;
        float sc = 1.f; if (split_cols) { const int t = colt / split_cols; base += (size_t)t * split_stride; colt -= t * split_cols; if (t == 0) sc = scale0; }
        const int col0 = colt + wc * 32 + 8 * fq, bcol0 = u.pn * BM + wc * 32 + 8 * fq;
        f32x4 bv[2][2];
#pragma unroll
        for (int bj = 0; bj < 2; ++bj)
#pragma unroll
            for (int n = 0; n < 2; ++n) bv[bj][n] = bias ? *(const f32x4*)(bias + bcol0 + bj * HALF + 4 * n) : (f32x4){0.f, 0.f, 0.f, 0.f};
#pragma unroll
        for (int ai = 0; ai < 2; ++ai)
#pragma unroll
            for (int m = 0; m < 4; ++m) { bf16_t* rowp = base + (size_t)(row0 + ai * HALF + m * 16) * ldc + col0;
#pragma unroll
                for (int bj = 0; bj < 2; ++bj) { f32x4 v0 = acc[ai][bj][m][0] + bv[bj][0], v1 = acc[ai][bj][m][1] + bv[bj][1];
                    if (ACT == 1) { f32x2 a = gelu_pk((f32x2){v0[0], v0[1]}), b = gelu_pk((f32x2){v0[2], v0[3]}), c = gelu_pk((f32x2){v1[0], v1[1]}), d = gelu_pk((f32x2){v1[2], v1[3]});
                        v0 = (f32x4){a.x, a.y, b.x, b.y}; v1 = (f32x4){c.x, c.y, d.x, d.y}; }
                    v0 = v0 * sc; v1 = v1 * sc; u32x4 w; w.x = cvt_pk_bf16(v0[0], v0[1]); w.y = cvt_pk_bf16(v0[2], v0[3]); w.z = cvt_pk_bf16(v1[0], v1[1]); w.w = cvt_pk_bf16(v1[2], v1[3]);
                    *(u32x4*)(rowp + bj * HALF) = w; } }
    }
};
template <class Epi, class Sched, bool ALIGN_EPI = false, bool SP2 = false>
__device__ __forceinline__ void gemm_phase(PG8_LAS unsigned char* lds, const Gemm g, const Sched& S, const Epi& E) {
    int tid_ = threadIdx.x; asm volatile("" : "+v"(tid_));
    const int tid = tid_, wid = __builtin_amdgcn_readfirstlane(tid >> 6), lane = tid & 63, wr = wid >> 2, wc = wid & 3, fr = lane & 15, fq = lane >> 4;
    const int K = g.K, nt = K / BK;
    unsigned voffA[2], voffB[2];
#pragma unroll
    for (int i = 0; i < 2; ++i) { int R, C; stage_rc(tid * 16 + i * 8192, R, C); const int Rb = Epi::PERM ? ((R & ~31) + perm32(R & 31)) : R;
        voffA[i] = (unsigned)(R * K + C) * 2u; voffB[i] = (unsigned)(Rb * K + C) * 2u; }
    const size_t kstep = (size_t)(BK * 2);
    const size_t hstep = (size_t)HALF * K * 2;
    const size_t tstep = 2 * hstep;
    const unsigned ldsw = (unsigned)wid * 1024u;
    const int aoff = lds_byte(wr * 64 + fr, fq * 8), boff = lds_byte(wc * 32 + fr, fq * 8);
#define PG8_SA(b, h) (((b) * 2 + (h)) * HTB)
#define PG8_SB(b, h) ((4 + (b) * 2 + (h)) * HTB)
#define PG8_STAGE(bufoff, gbase, voff) do { _Pragma("unroll") for (int _i = 0; _i < 2; ++_i) \
        __builtin_amdgcn_global_load_lds((const unsigned*)((const char*)(gbase) + (voff)[_i]), (PG8_LAS unsigned*)(lds + (bufoff) + ldsw + _i * 8192), 16, 0, 0); } while (0)
#define PG8_LDA(dst, b, h) do { _Pragma("unroll") for (int m = 0; m < 4; ++m) _Pragma("unroll") for (int k = 0; k < 2; ++k) dst[m][k] = *(const PG8_LAS bf16x8*)(lds + PG8_SA(b, h) + aoff + m * 2048 + k * 1024); } while (0)
#define PG8_LDB(dst, b, h) do { _Pragma("unroll") for (int n = 0; n < 2; ++n) _Pragma("unroll") for (int k = 0; k < 2; ++k) dst[n][k] = *(const PG8_LAS bf16x8*)(lds + PG8_SB(b, h) + boff + n * 2048 + k * 1024); } while (0)
#define PG8_MMA(ai, bj, At, Bt) do { __builtin_amdgcn_s_setprio(1); _Pragma("unroll") for (int m = 0; m < 4; ++m) _Pragma("unroll") for (int n = 0; n < 2; ++n) _Pragma("unroll") for (int k = 0; k < 2; ++k) \
        acc[ai][bj][m][n] = __builtin_amdgcn_mfma_f32_16x16x32_bf16(Bt[n][k], At[m][k], acc[ai][bj][m][n], 0, 0, 0); __builtin_amdgcn_s_setprio(0); } while (0)
#define PG8_WAIT_V(n) asm volatile("s_waitcnt vmcnt(" #n ")" ::: "memory")
#define PG8_WAIT_L(n) asm volatile("s_waitcnt lgkmcnt(" #n ")" ::: "memory")
#define PG8_BAR __builtin_amdgcn_s_barrier()
#define PG8_SCHED __builtin_amdgcn_sched_barrier(0)
    Unit cur, nxt; int ui = 0;
    if (!S.next(0, cur)) return;
    f32x4 acc[2][2][4][2];
#pragma unroll
    for (int a = 0; a < 2; ++a)
#pragma unroll
        for (int b = 0; b < 2; ++b)
#pragma unroll
            for (int m = 0; m < 4; ++m)
#pragma unroll
                for (int n = 0; n < 2; ++n) acc[a][b][m][n] = (f32x4){0.f, 0.f, 0.f, 0.f};
    bf16x8 At[4][2], B0[2][2], B1[2][2];
    const char* cA = (const char*)g.A + (size_t)cur.pm * tstep; const char* cB = (const char*)g.Bt + (size_t)cur.pn * tstep;
    S.a_ready(cur);
    if constexpr (SP2) {
        PG8_STAGE(PG8_SB(0, 0), cB, voffB); PG8_STAGE(PG8_SB(0, 1), cB + hstep, voffB); PG8_STAGE(PG8_SA(0, 0), cA, voffA); PG8_STAGE(PG8_SA(0, 1), cA + hstep, voffA);
        if (wr == 1) PG8_BAR;
        PG8_WAIT_V(2); PG8_BAR;
        PG8_STAGE(PG8_SB(1, 0), cB + kstep, voffB); PG8_STAGE(PG8_SA(1, 0), cA + kstep, voffA); PG8_STAGE(PG8_SB(1, 1), cB + hstep + kstep, voffB);
        PG8_WAIT_V(6); PG8_BAR;
    } else {
        PG8_STAGE(PG8_SB(0, 0), cB, voffB); PG8_STAGE(PG8_SA(0, 0), cA, voffA); PG8_STAGE(PG8_SB(0, 1), cB + hstep, voffB); PG8_STAGE(PG8_SA(0, 1), cA + hstep, voffA);
        if (wr == 1) PG8_BAR;
        PG8_WAIT_V(4); PG8_BAR;
        PG8_STAGE(PG8_SB(1, 0), cB + kstep, voffB); PG8_STAGE(PG8_SA(1, 0), cA + kstep, voffA); PG8_STAGE(PG8_SB(1, 1), cB + hstep + kstep, voffB);
        PG8_WAIT_V(6); PG8_BAR;
    }
    for (;;) {
        const bool has_next = S.next(ui + 1, nxt);
        const char* nA = has_next ? (const char*)g.A + (size_t)nxt.pm * tstep : cA; const char* nB = has_next ? (const char*)g.Bt + (size_t)nxt.pn * tstep : cB;
        for (int t = 0; t < nt; t += 2) {
            const bool last = (t == nt - 2);
            const char* a1 = cA + (size_t)(t + 1) * kstep;
            const char* a2 = last ? nA : cA + (size_t)(t + 2) * kstep; const char* b2 = last ? nB : cB + (size_t)(t + 2) * kstep;
            const char* a3 = a2 + kstep; const char* b3 = b2 + kstep;
            if (last && has_next) S.a_ready(nxt);
            if constexpr (SP2) {
            PG8_LDB(B0, 0, 0); PG8_LDB(B1, 0, 1); PG8_SCHED; PG8_LDA(At, 0, 0); PG8_STAGE(PG8_SA(1, 1), a1 + hstep, voffA);
            PG8_WAIT_V(8); PG8_WAIT_L(0); PG8_BAR; PG8_MMA(0, 0, At, B0); PG8_MMA(0, 1, At, B1); PG8_BAR; PG8_SCHED;
            PG8_LDA(At, 0, 1); PG8_STAGE(PG8_SB(0, 0), b2, voffB); PG8_STAGE(PG8_SB(0, 1), b2 + hstep, voffB); PG8_STAGE(PG8_SA(0, 0), a2, voffA);
            PG8_WAIT_V(8); PG8_WAIT_L(0); PG8_BAR; PG8_MMA(1, 0, At, B0); PG8_MMA(1, 1, At, B1); PG8_BAR; PG8_SCHED;
            PG8_LDB(B0, 1, 0); PG8_LDB(B1, 1, 1); PG8_SCHED; PG8_LDA(At, 1, 0); PG8_STAGE(PG8_SA(0, 1), a2 + hstep, voffA);
            PG8_WAIT_V(8); PG8_WAIT_L(0); PG8_BAR; PG8_MMA(0, 0, At, B0); PG8_MMA(0, 1, At, B1); PG8_BAR; PG8_SCHED;
            PG8_LDA(At, 1, 1); PG8_STAGE(PG8_SB(1, 0), b3, voffB); PG8_STAGE(PG8_SB(1, 1), b3 + hstep, voffB); PG8_STAGE(PG8_SA(1, 0), a3, voffA);
            PG8_WAIT_V(8); PG8_WAIT_L(0); PG8_BAR; PG8_MMA(1, 0, At, B0); PG8_MMA(1, 1, At, B1); PG8_BAR; PG8_SCHED;
            } else {
            PG8_LDB(B0, 0, 0); PG8_SCHED; PG8_LDA(At, 0, 0); PG8_STAGE(PG8_SA(1, 1), a1 + hstep, voffA);
            PG8_WAIT_L(8); PG8_BAR; PG8_WAIT_L(0); PG8_MMA(0, 0, At, B0); PG8_BAR; PG8_SCHED;
            PG8_LDB(B1, 0, 1); PG8_STAGE(PG8_SB(0, 0), b2, voffB);
            PG8_BAR; PG8_WAIT_L(0); PG8_MMA(0, 1, At, B1); PG8_BAR;
            PG8_LDA(At, 0, 1); PG8_STAGE(PG8_SA(0, 0), a2, voffA);
            PG8_BAR; PG8_WAIT_L(0); PG8_MMA(1, 0, At, B0); PG8_BAR; PG8_SCHED;
            PG8_STAGE(PG8_SB(0, 1), b2 + hstep, voffB);
            PG8_WAIT_V(6); PG8_BAR; PG8_MMA(1, 1, At, B1); PG8_BAR;
            PG8_LDB(B0, 1, 0); PG8_SCHED; PG8_LDA(At, 1, 0); PG8_STAGE(PG8_SA(0, 1), a2 + hstep, voffA);
            PG8_WAIT_L(8); PG8_BAR; PG8_WAIT_L(0); PG8_MMA(0, 0, At, B0); PG8_BAR; PG8_SCHED;
            PG8_LDB(B1, 1, 1); PG8_STAGE(PG8_SB(1, 0), b3, voffB);
            PG8_BAR; PG8_WAIT_L(0); PG8_MMA(0, 1, At, B1); PG8_BAR;
            PG8_LDA(At, 1, 1); PG8_STAGE(PG8_SA(1, 0), a3, voffA);
            PG8_BAR; PG8_WAIT_L(0); PG8_MMA(1, 0, At, B0); PG8_BAR; PG8_SCHED;
            PG8_STAGE(PG8_SB(1, 1), b3 + hstep, voffB);
            PG8_WAIT_V(6); PG8_BAR; PG8_MMA(1, 1, At, B1); PG8_BAR;
            }
        }
        if constexpr (ALIGN_EPI) { if (wr == 0) PG8_BAR; }
        if constexpr (!Epi::AFTER_DRAIN) { E(acc, cur, wr, wc, fr, fq); S.done(cur); }
        if (!has_next) break;
#pragma unroll
        for (int a = 0; a < 2; ++a)
#pragma unroll
            for (int b = 0; b < 2; ++b)
#pragma unroll
                for (int m = 0; m < 4; ++m)
#pragma unroll
                    for (int n = 0; n < 2; ++n) acc[a][b][m][n] = (f32x4){0.f, 0.f, 0.f, 0.f};
        cur = nxt; cA = nA; cB = nB; ++ui;
        if constexpr (ALIGN_EPI) { if (wr == 1) PG8_BAR; }
    }
    PG8_WAIT_V(0);
    if constexpr (!ALIGN_EPI) { if (wr == 0) PG8_BAR; }
    PG8_BAR;
    if constexpr (Epi::AFTER_DRAIN) { E.fused(acc, cur, wr, wc, fr, fq, lds, wid, lane); S.done(cur); }
#undef PG8_SA
#undef PG8_SB
#undef PG8_STAGE
#undef PG8_LDA
#undef PG8_LDB
#undef PG8_MMA
#undef PG8_WAIT_V
#undef PG8_WAIT_L
#undef PG8_BAR
#undef PG8_SCHED
}
}
#ifndef MK_SPLIT
#define MK_SPLIT 0
#endif
namespace mk {
#define LAS __attribute__((address_space(3)))
typedef unsigned short bf16_t;
typedef short bf16x8 __attribute__((ext_vector_type(8)));
typedef short s16x4 __attribute__((ext_vector_type(4)));
typedef float f32x4 __attribute__((ext_vector_type(4)));
typedef float f32x2 __attribute__((ext_vector_type(2)));
typedef float f32x16 __attribute__((ext_vector_type(16)));
typedef unsigned u32x4 __attribute__((ext_vector_type(4)));
typedef unsigned u32x2 __attribute__((ext_vector_type(2)));
using pg8::Unit;

constexpr int BATCH = 4, SEQ = 8192, DM = 1024, T = BATCH * SEQ, NH = 8;
constexpr int D_IN = 2464, N_IN = 2560;
constexpr float EPS = 1e-5f;
constexpr float DN_ALPHA = 1.189207115002721f;
constexpr float QSCALE = 0.10206207261596575f * 1.4426950408889634f;
constexpr int NWAVES = 8, NTHREADS = 512;

constexpr size_t MiB = 1u << 20;
constexpr size_t WS_WIN = 2 * MiB, WS_WUQ = 8 * MiB, WS_WUKV = 9 * MiB, WS_WOUT = 10 * MiB, WS_WSP = 12 * MiB;
constexpr size_t WS_SSQQ = 13 * MiB, WS_SSQKV = 13 * MiB + 512 * 1024, WS_VSTAT = 14 * MiB;
constexpr size_t WS_XB = 32 * MiB, WS_CQ = 96 * MiB, WS_CKV = 112 * MiB, WS_KR = 120 * MiB;
constexpr size_t WS_SZA = 128 * MiB, WS_GU = 160 * MiB, WS_GV = 192 * MiB, WS_SZB = 224 * MiB;
constexpr size_t WS_QN = 256 * MiB, WS_QR = 288 * MiB, WS_KN = 304 * MiB, WS_VV = 336 * MiB, WS_MG = 368 * MiB, WS_END = 432 * MiB;

constexpr size_t WS_BAR = 0, BAR_BYTES = 16384;
constexpr int LDS_MISC = 131072 + 320;
constexpr int LDS_BYTES = 147456;

__device__ const float INVF[16] = {1.0f, 0.5623413324356079f, 0.3162277638912201f, 0.17782793939113617f, 0.10000000149011612f, 0.05623412877321243f,
    0.03162277862429619f, 0.017782794311642647f, 0.009999999776482582f, 0.005623413249850273f, 0.003162277862429619f, 0.0017782794311642647f,
    0.0010000000474974513f, 0.000562341301701963f, 0.0003162277862429619f, 0.00017782794020604342f};

__device__ __forceinline__ unsigned cvt2(float lo, float hi) { return pg8::cvt_pk_bf16(lo, hi); }
__device__ __forceinline__ u32x4 pack8(const f32x4 a, const f32x4 b) { u32x4 w; w.x = cvt2(a[0], a[1]); w.y = cvt2(a[2], a[3]); w.z = cvt2(b[0], b[1]); w.w = cvt2(b[2], b[3]); return w; }
__device__ __forceinline__ u32x2 pack4(const f32x4 a) { u32x2 w; w.x = cvt2(a[0], a[1]); w.y = cvt2(a[2], a[3]); return w; }
__device__ __forceinline__ float bf_lo(unsigned u) { return __uint_as_float(u << 16); }
__device__ __forceinline__ float bf_hi(unsigned u) { return __uint_as_float(u & 0xffff0000u); }
__device__ __forceinline__ f32x4 unpack4(const u32x2 w) { return (f32x4){bf_lo(w.x), bf_hi(w.x), bf_lo(w.y), bf_hi(w.y)}; }
__device__ __forceinline__ float silu_f(float x) { return x / (1.f + __expf(-x)); }
__device__ __forceinline__ f32x4 silu4(const f32x4 v) { return (f32x4){silu_f(v[0]), silu_f(v[1]), silu_f(v[2]), silu_f(v[3])}; }
__device__ __forceinline__ f32x4 gelu4(const f32x4 v) { const f32x2 a = pg8::gelu_pk((f32x2){v[0], v[1]}), b = pg8::gelu_pk((f32x2){v[2], v[3]}); return (f32x4){a.x, a.y, b.x, b.y}; }
__device__ __forceinline__ float sum4(const f32x4 v) { return (v[0] + v[1]) + (v[2] + v[3]); }
__device__ __forceinline__ float ssq4(const f32x4 v) { return (v[0] * v[0] + v[1] * v[1]) + (v[2] * v[2] + v[3] * v[3]); }
__device__ __forceinline__ float quad_sum(float s) { s += __shfl_xor(s, 16); s += __shfl_xor(s, 32); return s; }
__device__ __forceinline__ float wave_sum(float v) {
#pragma unroll
    for (int o = 1; o < 64; o <<= 1) v += __shfl_xor(v, o);
    return v;
}
__device__ __forceinline__ void rope4(const f32x4 t1, const f32x4 t2, int pos, int fq, f32x4& o1, f32x4& o2) {
    const float pf = (float)pos;
#pragma unroll
    for (int e = 0; e < 4; ++e) {
        const float ang = pf * INVF[4 * fq + e];
        const double x = (double)ang * 0.15915494309189535;
        const float fr = (float)(x - __builtin_rint(x));
        const float s = __builtin_amdgcn_sinf(fr), c = __builtin_amdgcn_cosf(fr);
        o1[e] = t1[e] * c - t2[e] * s; o2[e] = t1[e] * s + t2[e] * c;
    }
}

struct EpiInProj {
    static constexpr bool PERM = true, AFTER_DRAIN = false;
    bf16_t *CQ, *CKV, *KR, *ACT; float *SSQQ, *SSQKV, *VSTAT; const int* pos;
    __device__ __forceinline__ void operator()(const f32x4 (&acc)[2][2][4][2], const Unit& u, int wr, int wc, int fr, int fq) const {
        asm volatile("" : "+v"(fr), "+v"(fq));
        const int pn = u.pn, row0 = u.pm * 256 + wr * 64 + fr, cw = wc * 32 + 8 * fq;
        if (pn == 0) {
#pragma unroll
            for (int ai = 0; ai < 2; ++ai)
#pragma unroll
                for (int m = 0; m < 4; ++m) { const size_t row = row0 + ai * 128 + m * 16; float ss = 0.f;
#pragma unroll
                    for (int bj = 0; bj < 2; ++bj) { const f32x4 v0 = acc[ai][bj][m][0], v1 = acc[ai][bj][m][1]; ss += ssq4(v0) + ssq4(v1);
                        *(u32x4*)(CQ + row * 256 + bj * 128 + cw) = pack8(v0, v1); }
                    ss = quad_sum(ss); if (fq == 0) SSQQ[row * 4 + wc] = ss; }
        } else if (pn == 1) {
#pragma unroll
            for (int ai = 0; ai < 2; ++ai)
#pragma unroll
                for (int m = 0; m < 4; ++m) { const size_t row = row0 + ai * 128 + m * 16;
                    const f32x4 v0 = acc[ai][0][m][0], v1 = acc[ai][0][m][1]; float ss = ssq4(v0) + ssq4(v1);
                    *(u32x4*)(CKV + row * 128 + cw) = pack8(v0, v1);
                    ss = quad_sum(ss); if (fq == 0) SSQKV[row * 4 + wc] = ss;
                    if (wc == 0) { f32x4 o1, o2; rope4(acc[ai][1][m][0], acc[ai][1][m][1], pos[row], fq, o1, o2);
                        *(u32x2*)(KR + row * 32 + 4 * fq) = pack4(o1); *(u32x2*)(KR + row * 32 + 16 + 4 * fq) = pack4(o2); } }
        } else {
            const int seg = (pn - 2) >> 1, half = (pn - 2) & 1;
            bf16_t* dst = ACT + (size_t)seg * (16u << 20);
            const bool is_gelu = (seg == 1 || seg == 2);
#pragma unroll
            for (int ai = 0; ai < 2; ++ai)
#pragma unroll
                for (int m = 0; m < 4; ++m) { const size_t row = row0 + ai * 128 + m * 16; float s1 = 0.f, s2 = 0.f;
#pragma unroll
                    for (int bj = 0; bj < 2; ++bj) { f32x4 v0 = acc[ai][bj][m][0], v1 = acc[ai][bj][m][1];
                        if (is_gelu) { v0 = gelu4(v0); v1 = gelu4(v1); } else { v0 = silu4(v0); v1 = silu4(v1); }
                        s1 += sum4(v0) + sum4(v1); s2 += ssq4(v0) + ssq4(v1);
                        *(u32x4*)(dst + row * 512 + half * 256 + bj * 128 + cw) = pack8(v0, v1); }
                    if (seg == 2) { s1 = quad_sum(s1); s2 = quad_sum(s2); if (fq == 0) *(f32x2*)(VSTAT + (row * 8 + half * 4 + wc) * 2) = (f32x2){s1, s2}; } }
        }
    }
};
struct EpiQUp {
    static constexpr bool PERM = true, AFTER_DRAIN = false;
    bf16_t *QN, *QR; const float* SSQQ; const int* pos;
    __device__ __forceinline__ void operator()(const f32x4 (&acc)[2][2][4][2], const Unit& u, int wr, int wc, int fr, int fq) const {
        asm volatile("" : "+v"(fr), "+v"(fq));
        const int pn = u.pn, row0 = u.pm * 256 + wr * 64 + fr, cw = wc * 32 + 8 * fq;
#pragma unroll
        for (int ai = 0; ai < 2; ++ai)
#pragma unroll
            for (int m = 0; m < 4; ++m) { const size_t row = row0 + ai * 128 + m * 16;
                const f32x4 sq = *(const f32x4*)(SSQQ + row * 4);
                const float sc = QSCALE / sqrtf(sum4(sq) * (1.f / 256.f) + EPS);
                if (pn < 2) {
#pragma unroll
                    for (int bj = 0; bj < 2; ++bj) *(u32x4*)(QN + row * 512 + pn * 256 + bj * 128 + cw) = pack8(acc[ai][bj][m][0] * sc, acc[ai][bj][m][1] * sc);
                } else { const int p = pos[row];
#pragma unroll
                    for (int bj = 0; bj < 2; ++bj) { const int head = bj * 4 + wc; f32x4 o1, o2; rope4(acc[ai][bj][m][0] * sc, acc[ai][bj][m][1] * sc, p, fq, o1, o2);
                        *(u32x2*)(QR + row * 256 + head * 32 + 4 * fq) = pack4(o1); *(u32x2*)(QR + row * 256 + head * 32 + 16 + 4 * fq) = pack4(o2); asm volatile("" ::: "memory"); } }
                asm volatile("" ::: "memory");
            }
    }
};
struct EpiKVUp {
    static constexpr bool PERM = true, AFTER_DRAIN = false;
    bf16_t *KN; const float* SSQKV;
    __device__ __forceinline__ void operator()(const f32x4 (&acc)[2][2][4][2], const Unit& u, int wr, int wc, int fr, int fq) const {
        asm volatile("" : "+v"(fr), "+v"(fq));
        const int pn = u.pn, row0 = u.pm * 256 + wr * 64 + fr, cw = wc * 32 + 8 * fq;
        bf16_t* dst = KN + (size_t)(pn >> 1) * (16u << 20) + (pn & 1) * 256;
#pragma unroll
        for (int ai = 0; ai < 2; ++ai)
#pragma unroll
            for (int m = 0; m < 4; ++m) { const size_t row = row0 + ai * 128 + m * 16;
                const f32x4 sq = *(const f32x4*)(SSQKV + row * 4);
                const float sc = 1.f / sqrtf(sum4(sq) * (1.f / 128.f) + EPS);
#pragma unroll
                for (int bj = 0; bj < 2; ++bj) *(u32x4*)(dst + row * 512 + bj * 128 + cw) = pack8(acc[ai][bj][m][0] * sc, acc[ai][bj][m][1] * sc); }
    }
};
struct EpiOut {
    static constexpr bool PERM = true, AFTER_DRAIN = false;
    const float* x; float* out;
    __device__ __forceinline__ void operator()(const f32x4 (&acc)[2][2][4][2], const Unit& u, int wr, int wc, int fr, int fq) const {
        asm volatile("" : "+v"(fr), "+v"(fq));
        const int row0 = u.pm * 256 + wr * 64 + fr, col0 = u.pn * 256 + wc * 32 + 8 * fq;
#pragma unroll
        for (int ai = 0; ai < 2; ++ai)
#pragma unroll
            for (int m = 0; m < 4; ++m) { const size_t off = (size_t)(row0 + ai * 128 + m * 16) * DM + col0;
#pragma unroll
                for (int bj = 0; bj < 2; ++bj) { const f32x4 x0 = *(const f32x4*)(x + off + bj * 128), x1 = *(const f32x4*)(x + off + bj * 128 + 4);
                    *(f32x4*)(out + off + bj * 128) = x0 * DN_ALPHA + acc[ai][bj][m][0]; *(f32x4*)(out + off + bj * 128 + 4) = x1 * DN_ALPHA + acc[ai][bj][m][1]; } }
    }
};

__device__ __forceinline__ int rope_perm(int pp) { const int fq = pp >> 3, j = pp & 7; return (j < 4) ? 4 * fq + j : 16 + 4 * fq + (j - 4); }
__device__ __forceinline__ int src_col(int kind, int n) {
    if (kind == 0) {
        if (n < 384) return n; if (n < 416) return 384 + rope_perm(n - 384); if (n < 512) return -1; return n - 96;
    } else if (kind == 1) {
        if (n < 512) return (n >> 6) * 96 + (n & 63); const int p = n - 512; return (p >> 5) * 96 + 64 + rope_perm(p & 31);
    } else if (kind == 2) {
        if (n < 512) return (n >> 6) * 128 + (n & 63); const int p = n - 512; return (p >> 6) * 128 + 64 + (p & 63);
    }
    return n;
}
__device__ __forceinline__ void transpose_item(const float* W, int K, int Nsrc, int Ndst, bf16_t* WT, int kind, const float* kscale, LAS float* scr, int item, int lane) {
    const int nblk = Ndst / 32, kb = item / nblk, nb = item % nblk, k0 = 64 * kb, n0 = 32 * nb;
    const int sc = src_col(kind, n0 + (lane & 31));
#pragma unroll 8
    for (int i = 0; i < 32; ++i) { const int kk = 2 * i + (lane >> 5); float v = 0.f;
        if (sc >= 0) { v = W[(size_t)(k0 + kk) * Nsrc + sc]; if (kscale) v *= kscale[k0 + kk]; }
        scr[kk * 33 + (lane & 31)] = v; }
    asm volatile("s_waitcnt lgkmcnt(0)" ::: "memory");
    const int c = lane & 7;
#pragma unroll
    for (int j = 0; j < 4; ++j) { const int n = (lane >> 3) + 8 * j; const LAS float* s = scr + (8 * c) * 33 + n;
        u32x4 o; o.x = cvt2(s[0 * 33], s[1 * 33]); o.y = cvt2(s[2 * 33], s[3 * 33]); o.z = cvt2(s[4 * 33], s[5 * 33]); o.w = cvt2(s[6 * 33], s[7 * 33]);
        *(u32x4*)(WT + (size_t)(n0 + n) * K + k0 + 8 * c) = o; }
    asm volatile("s_waitcnt lgkmcnt(0)" ::: "memory");
}

__device__ __forceinline__ int crow(int r, int hi) { return (r & 3) + 8 * (r >> 2) + 4 * hi; }
__device__ __forceinline__ s16x4 vtr(const LAS unsigned char* p) { typedef short v4i16_t __attribute__((ext_vector_type(4)));
    return __builtin_bit_cast(s16x4, __builtin_amdgcn_ds_read_tr16_b64_v4i16((LAS v4i16_t*)p)); }
constexpr int ATT_KSLOT = 12288, ATT_VSLOT = 8192, ATT_VOFF = 2 * ATT_KSLOT;
struct AttT { const bf16_t *QN, *QR, *KN, *KR, *VV, *SZA; bf16_t* MG; };

__device__ __forceinline__ void attn_unit(int b, int h, int qb, const AttT& A, LAS unsigned char* lds) {
    int tid_ = threadIdx.x; asm volatile("" : "+v"(tid_));
    const int tid = tid_, lane = tid & 63, r32 = lane & 31, hi = lane >> 5;
    const int wid = __builtin_amdgcn_readfirstlane(tid >> 6);
    const size_t rowbase = (size_t)b * SEQ; const int q0 = qb * 256;
    const size_t qrow = rowbase + q0 + wid * 32 + r32;
    bf16x8 qf[6];
#pragma unroll
    for (int d0 = 0; d0 < 4; ++d0) qf[d0] = *(const bf16x8*)(A.QN + qrow * 512 + h * 64 + d0 * 16 + hi * 8);
#pragma unroll
    for (int d0 = 0; d0 < 2; ++d0) qf[4 + d0] = *(const bf16x8*)(A.QR + qrow * 256 + h * 32 + d0 * 16 + hi * 8);
    const int NT = (q0 + 256) / 64, tl = (q0 + wid * 32) >> 6;
    const bf16_t* kn_src = A.KN + (rowbase + lane) * 512 + h * 64 + wid * 8;
    const bf16_t* kr_src = A.KR + (rowbase + lane) * 32 + (wid & 3) * 8;
    const bf16_t* v_src = A.VV + (rowbase + (wid & 3) * 16 + (lane >> 2)) * 512 + h * 64 + (wid >> 2) * 32 + (lane & 3) * 8;
    const int kn_dst = wid * 1024 + lane * 16, kr_dst = (8 + (wid & 3)) * 1024 + lane * 16, v_dst = ATT_VOFF + wid * 1024 + lane * 16;
    u32x4 rk0, rk1 = (u32x4){0u, 0u, 0u, 0u}, rv;
#define ATT_LOAD(t) do { rk0 = *(const u32x4*)(kn_src + (size_t)(t) * 64 * 512); if (wid < 4) rk1 = *(const u32x4*)(kr_src + (size_t)(t) * 64 * 32); rv = *(const u32x4*)(v_src + (size_t)(t) * 64 * 512); } while (0)
#define ATT_STORE(buf) do { *(LAS u32x4*)(lds + (buf) * ATT_KSLOT + kn_dst) = rk0; if (wid < 4) *(LAS u32x4*)(lds + (buf) * ATT_KSLOT + kr_dst) = rk1; *(LAS u32x4*)(lds + (buf) * ATT_VSLOT + v_dst) = rv; } while (0)
    ATT_LOAD(0); ATT_STORE(0);
    __syncthreads();
    float m_run = -INFINITY, l_run = 0.f;
    f32x16 o0, o1;
#pragma unroll
    for (int r = 0; r < 16; ++r) { o0[r] = 0.f; o1[r] = 0.f; }
    const int kfb = hi * 1024 + r32 * 16;
    const int vfb = ATT_VOFF + (4 * hi + ((lane & 15) >> 2)) * 64 + ((lane >> 4) & 1) * 32 + (lane & 3) * 8;
    for (int t = 0; t < NT; ++t) {
        const int cur = t & 1;
        if (t + 1 < NT) ATT_LOAD(t + 1);
        if (t <= tl) {
            const LAS unsigned char* kb = lds + cur * ATT_KSLOT + kfb;
            f32x16 p0, p1;
#pragma unroll
            for (int r = 0; r < 16; ++r) { p0[r] = 0.f; p1[r] = 0.f; }
#pragma unroll
            for (int d0 = 0; d0 < 6; ++d0) {
                const bf16x8 k0 = *(const LAS bf16x8*)(kb + d0 * 2048), k1 = *(const LAS bf16x8*)(kb + d0 * 2048 + 512);
                p0 = __builtin_amdgcn_mfma_f32_32x32x16_bf16(k0, qf[d0], p0, 0, 0, 0);
                p1 = __builtin_amdgcn_mfma_f32_32x32x16_bf16(k1, qf[d0], p1, 0, 0, 0);
            }
            if (t == tl) {
                const int qrel = q0 + wid * 32 + r32 - 64 * t;
#pragma unroll
                for (int r = 0; r < 16; ++r) { const int kv = crow(r, hi); if (kv > qrel) p0[r] = -INFINITY; if (kv + 32 > qrel) p1[r] = -INFINITY; }
            }
            float mx = fmaxf(p0[0], p1[0]);
#pragma unroll
            for (int r = 1; r < 16; ++r) mx = fmaxf(mx, fmaxf(p0[r], p1[r]));
            mx = fmaxf(mx, __shfl_xor(mx, 32));
            const float m_new = fmaxf(m_run, mx);
            const float alpha = __builtin_amdgcn_exp2f(m_run - m_new);
            float ls = 0.f;
#pragma unroll
            for (int r = 0; r < 16; ++r) { p0[r] = __builtin_amdgcn_exp2f(p0[r] - m_new); p1[r] = __builtin_amdgcn_exp2f(p1[r] - m_new); ls += p0[r] + p1[r]; }
            l_run = l_run * alpha + ls; m_run = m_new;
            if (__any(alpha != 1.f)) {
#pragma unroll
                for (int r = 0; r < 16; ++r) { o0[r] *= alpha; o1[r] *= alpha; }
            }
            bf16x8 pf[4];
            { u32x4 w;
              w.x = cvt2(p0[0], p0[1]); w.y = cvt2(p0[2], p0[3]); w.z = cvt2(p0[4], p0[5]); w.w = cvt2(p0[6], p0[7]); pf[0] = __builtin_bit_cast(bf16x8, w);
              w.x = cvt2(p0[8], p0[9]); w.y = cvt2(p0[10], p0[11]); w.z = cvt2(p0[12], p0[13]); w.w = cvt2(p0[14], p0[15]); pf[1] = __builtin_bit_cast(bf16x8, w);
              w.x = cvt2(p1[0], p1[1]); w.y = cvt2(p1[2], p1[3]); w.z = cvt2(p1[4], p1[5]); w.w = cvt2(p1[6], p1[7]); pf[2] = __builtin_bit_cast(bf16x8, w);
              w.x = cvt2(p1[8], p1[9]); w.y = cvt2(p1[10], p1[11]); w.z = cvt2(p1[12], p1[13]); w.w = cvt2(p1[14], p1[15]); pf[3] = __builtin_bit_cast(bf16x8, w); }
            const LAS unsigned char* vb = lds + cur * ATT_VSLOT + vfb;
#pragma unroll
            for (int ks = 0; ks < 4; ++ks) {
                const s16x4 a0 = vtr(vb + ks * 1024), a1 = vtr(vb + ks * 1024 + 512), b0 = vtr(vb + 4096 + ks * 1024), b1 = vtr(vb + 4096 + ks * 1024 + 512);
                const bf16x8 va = (bf16x8){a0[0], a0[1], a0[2], a0[3], a1[0], a1[1], a1[2], a1[3]}, vbq = (bf16x8){b0[0], b0[1], b0[2], b0[3], b1[0], b1[1], b1[2], b1[3]};
                o0 = __builtin_amdgcn_mfma_f32_32x32x16_bf16(va, pf[ks], o0, 0, 0, 0);
                o1 = __builtin_amdgcn_mfma_f32_32x32x16_bf16(vbq, pf[ks], o1, 0, 0, 0);
            }
        }
        if (t + 1 < NT) ATT_STORE(cur ^ 1);
        __syncthreads();
    }
#undef ATT_LOAD
#undef ATT_STORE
    const float inv = 1.f / (l_run + __shfl_xor(l_run, 32));
    const bf16_t* zrow = A.SZA + qrow * 512 + h * 64; bf16_t* orow = A.MG + qrow * 1024 + h * 64;
#pragma unroll
    for (int j = 0; j < 4; ++j) { const int d = 8 * j + 4 * hi;
        const f32x4 z0 = unpack4(*(const u32x2*)(zrow + d)), z1 = unpack4(*(const u32x2*)(zrow + 32 + d));
        const f32x4 a = (f32x4){o0[4 * j], o0[4 * j + 1], o0[4 * j + 2], o0[4 * j + 3]} * inv * z0, c = (f32x4){o1[4 * j], o1[4 * j + 1], o1[4 * j + 2], o1[4 * j + 3]} * inv * z1;
        *(u32x2*)(orow + d) = pack4(a); *(u32x2*)(orow + 32 + d) = pack4(c); }
}

struct SguT { const bf16_t *GV, *GU, *SZB, *WSP; const float *VSTAT, *g, *bta, *bsp; bf16_t* MG; };
__device__ __forceinline__ void sgu_unit(int chunk, int h, const SguT& S, LAS unsigned char* lds) {
    int tid_ = threadIdx.x; asm volatile("" : "+v"(tid_));
    const int tid = tid_, lane = tid & 63, r32 = lane & 31, hi = lane >> 5;
    const int wid = __builtin_amdgcn_readfirstlane(tid >> 6);
    const size_t row0 = (size_t)chunk * 128;
    {
        const int s = tid >> 2, ch = tid & 3; const size_t row = row0 + s;
        const f32x4* st = (const f32x4*)(S.VSTAT + row * 16);
        const f32x4 a = st[0], b = st[1], c = st[2], d = st[3];
        const float s1 = (a[0] + a[2]) + (b[0] + b[2]) + (c[0] + c[2]) + (d[0] + d[2]), s2 = (a[1] + a[3]) + (b[1] + b[3]) + (c[1] + c[3]) + (d[1] + d[3]);
        const float mean = s1 * (1.f / 512.f), var = fmaxf(s2 * (1.f / 512.f) - mean * mean, 0.f), rstd = 1.f / sqrtf(var + EPS);
#pragma unroll
        for (int dh = 0; dh < 2; ++dh) { const int c0 = h * 64 + dh * 32 + ch * 8;
            const u32x4 raw = *(const u32x4*)(S.GV + row * 512 + c0);
            const f32x4 g0 = *(const f32x4*)(S.g + c0), g1 = *(const f32x4*)(S.g + c0 + 4), b0 = *(const f32x4*)(S.bta + c0), b1 = *(const f32x4*)(S.bta + c0 + 4);
            f32x4 v0 = (f32x4){bf_lo(raw.x), bf_hi(raw.x), bf_lo(raw.y), bf_hi(raw.y)}, v1 = (f32x4){bf_lo(raw.z), bf_hi(raw.z), bf_lo(raw.w), bf_hi(raw.w)};
            v0 = (v0 - mean) * rstd * g0 + b0; v1 = (v1 - mean) * rstd * g1 + b1;
            *(LAS u32x4*)(lds + dh * 8192 + s * 64 + ch * 16) = pack8(v0, v1); }
    }
    __syncthreads();
    const int db = wid & 1, tb = wid >> 1, t = 32 * tb + r32, nks = 2 * tb + 2;
    f32x16 acc;
#pragma unroll
    for (int r = 0; r < 16; ++r) acc[r] = 0.f;
    const LAS unsigned char* vb = lds + db * 8192 + (8 * hi + ((lane & 15) >> 2)) * 64 + ((lane >> 4) & 1) * 32 + (lane & 3) * 8;
    const bf16_t* wrow = S.WSP + ((size_t)h * 128 + t) * 128 + 8 * hi;
    for (int ks = 0; ks < nks; ++ks) {
        const s16x4 a0 = vtr(vb + ks * 1024), a1 = vtr(vb + ks * 1024 + 256);
        const bf16x8 va = (bf16x8){a0[0], a0[1], a0[2], a0[3], a1[0], a1[1], a1[2], a1[3]};
        const bf16x8 wf = *(const bf16x8*)(wrow + 16 * ks);
        acc = __builtin_amdgcn_mfma_f32_32x32x16_bf16(va, wf, acc, 0, 0, 0);
    }
    const float bias = S.bsp[h * 128 + t];
    const size_t row = row0 + t; const int cbase = h * 64 + 32 * db;
#pragma unroll
    for (int j = 0; j < 4; ++j) { const int c = cbase + 8 * j + 4 * hi;
        const f32x4 gu = unpack4(*(const u32x2*)(S.GU + row * 512 + c)), zb = unpack4(*(const u32x2*)(S.SZB + row * 512 + c));
        const f32x4 sv = (f32x4){acc[4 * j], acc[4 * j + 1], acc[4 * j + 2], acc[4 * j + 3]} + bias;
        *(u32x2*)(S.MG + row * 1024 + 512 + c) = pack4(sv * gu * zb); }
    __syncthreads();
}

#define XB_TMO      128
#define XB_XCNT(j)  (256  + 64 * (j))
#define XB_XSUB(j)  (1280 + 64 * (j))
#define XB_XGEN(j)  (2304 + 64 * (j))
#define XB_TOP      3328
#define XB_TOPGEN   3392
#define XCD_BAR_WORDS 3456
#define XB_SPIN_CAP (1u << 18)

__device__ __forceinline__ unsigned xb_ld(unsigned* p)              { return __hip_atomic_load(p, __ATOMIC_RELAXED, __HIP_MEMORY_SCOPE_AGENT); }
__device__ __forceinline__ unsigned xb_add(unsigned* p, unsigned v) { return __hip_atomic_fetch_add(p, v, __ATOMIC_RELAXED, __HIP_MEMORY_SCOPE_AGENT); }
__device__ __forceinline__ unsigned xb_xcc_id() { return (unsigned)__builtin_amdgcn_s_getreg((3 << 11) | 20) & 0xFu; }
#define XB_SPIN(cond, bar) do { unsigned _sp = 0; while (cond) { __builtin_amdgcn_s_sleep(1); \
    if ((++_sp & 255u) == 0u) { if (xb_ld(&(bar)[XB_TMO])) break; if (_sp > XB_SPIN_CAP) { atomicAdd(&(bar)[XB_TMO], 1u); break; } } } } while (0)

struct XcdBarrier {
    unsigned* bar; unsigned x;
    volatile LAS unsigned* st;
};

__device__ __forceinline__ XcdBarrier xcd_barrier_post(unsigned* bar, volatile LAS unsigned* st) {
    XcdBarrier b; b.bar = bar; b.x = xb_xcc_id(); b.st = st;
    if (threadIdx.x == 0) (void)xb_add(&bar[XB_XCNT(b.x)], 1u);
    return b;
}
__device__ __forceinline__ void xcd_barrier_complete(unsigned* bar, unsigned x, unsigned& nloc, unsigned& nx) {
    const unsigned G = gridDim.x * gridDim.y * gridDim.z;
    unsigned sum, cnt, mine, sp = 0u;
    for (;;) {
        sum = 0u; cnt = 0u; mine = 0u;
#pragma unroll
        for (unsigned j = 0; j < 16; ++j) { const unsigned c = xb_ld(&bar[XB_XCNT(j)]); sum += c; cnt += (c > 0u) ? 1u : 0u; mine = (j == x) ? c : mine; }
        if (sum == G) break;
        __builtin_amdgcn_s_sleep(1);
        if ((++sp & 255u) == 0u) { if (xb_ld(&bar[XB_TMO])) break; if (sp > XB_SPIN_CAP) { atomicAdd(&bar[XB_TMO], 1u); break; } }
    }
    nloc = mine > 0u ? mine : 1u; nx = cnt > 0u ? cnt : 1u;
}

__device__ __forceinline__ void xcd_barrier(const XcdBarrier& b) {
    asm volatile("s_waitcnt vmcnt(0)" ::: "memory");
    __syncthreads();
    if (threadIdx.x == 0) {
        unsigned* bar = b.bar;
        __builtin_amdgcn_s_waitcnt(0);
        unsigned nloc = b.st[0], nx = b.st[1];
        if (nloc == 0u) { xcd_barrier_complete(bar, b.x, nloc, nx); b.st[0] = nloc; b.st[1] = nx; }
        const unsigned old = xb_add(&bar[XB_XSUB(b.x)], 1u);
        const unsigned gen = old / nloc;
        if (old + 1u == (gen + 1u) * nloc) {
            __builtin_amdgcn_fence(__ATOMIC_RELEASE, "agent");
            asm volatile("s_waitcnt vmcnt(0)" ::: "memory");
            const unsigned og = xb_add(&bar[XB_TOP], 1u);
            const unsigned tg = og / nx;
            if (og + 1u == (tg + 1u) * nx) xb_add(&bar[XB_TOPGEN], 1u);
            else XB_SPIN(xb_ld(&bar[XB_TOPGEN]) == tg, bar);
            __builtin_amdgcn_fence(__ATOMIC_ACQUIRE, "agent");
            xb_add(&bar[XB_XGEN(b.x)], 1u);
            asm volatile("s_waitcnt vmcnt(0)" ::: "memory");
        } else {
            XB_SPIN(xb_ld(&bar[XB_XGEN(b.x)]) == gen, bar);
            __builtin_amdgcn_fence(__ATOMIC_ACQUIRE, "agent");
            asm volatile("s_waitcnt vmcnt(0)" ::: "memory");
        }
    }
    __syncthreads();
}

struct Args { const float* in[14]; float* out; unsigned char* ws; int ph_lo, ph_hi; };
static_assert(WS_GU - WS_SZA == 32 * MiB && WS_GV - WS_GU == 32 * MiB && WS_SZB - WS_GV == 32 * MiB && WS_VV - WS_KN == 32 * MiB, "epilogue pointer arithmetic");
static_assert(sizeof(Args) == 14 * 8 + 8 + 8 + 8, "Args has no padding");

__global__ void __launch_bounds__(NTHREADS, 2) mk_fwd(Args args) {
    extern __shared__ __attribute__((aligned(16))) unsigned char lds_raw[];
    LAS unsigned char* lds = (LAS unsigned char*)lds_raw;
    if (threadIdx.x < 32) ((LAS unsigned*)(lds + 131072))[threadIdx.x + 64] = 0u;
    __syncthreads();
    XcdBarrier bar = xcd_barrier_post((unsigned*)(args.ws + WS_BAR), (volatile LAS unsigned*)(lds + LDS_MISC));
    if (args.ph_lo < 0) cg::this_grid().sync();
    const int G = gridDim.x, bx = blockIdx.x, vcu = (G % 8 == 0) ? (bx % 8) * (G / 8) + bx / 8 : bx;
    const int lo = args.ph_lo, hi = args.ph_hi;
    const float* x = args.in[0]; const int* pos = (const int*)args.in[1];
#define WSPTR(name, type, off) unsigned char* name##_b = args.ws; asm volatile("" : "+s"(name##_b)); type* name = (type*)(name##_b + (off))
#ifndef MK_REP
#define MK_REP 0
#endif
#define REP(k) for (int rep_ = 0; rep_ < 1 + ((MK_REP >> (k)) & 1); ++rep_)
#ifndef MK_PHASES
#define MK_PHASES 63
#endif
#define IN(k) (((MK_PHASES >> (k)) & 1) && lo <= (k) && (k) < hi)
#define SEAM(k) do { if (IN(k) && IN((k) + 1)) { xcd_barrier(bar); } } while (0)

    if (IN(0)) REP(0) {
        const float *w_in = args.in[2], *q_g = args.in[3], *w_uq = args.in[4], *kv_g = args.in[5], *w_ukv = args.in[6], *w_sp = args.in[9], *w_out = args.in[11];
        WSPTR(WIN, bf16_t, WS_WIN); bf16_t *WUQ = WIN + (WS_WUQ - WS_WIN) / 2, *WUKV = WIN + (WS_WUKV - WS_WIN) / 2, *WOUT = WIN + (WS_WOUT - WS_WIN) / 2, *WSP = WIN + (WS_WSP - WS_WIN) / 2, *XB = WIN + (WS_XB - WS_WIN) / 2;
        int tid = threadIdx.x; asm volatile("" : "+v"(tid)); const int lane = tid & 63, wave = __builtin_amdgcn_readfirstlane(tid >> 6);
        LAS float* scr = (LAS float*)(lds + wave * 16384);
        const int gw = vcu * NWAVES + wave, NGW = G * NWAVES;
        constexpr int I_IN = (DM / 64) * (N_IN / 32), I_UQ = (256 / 64) * (768 / 32), I_UKV = (128 / 64) * (1024 / 32), I_OUT = (DM / 64) * (DM / 32);
        for (int it = gw; it < I_IN + I_UQ + I_UKV + I_OUT; it += NGW) {
            int r = it;
            if (r < I_IN) { transpose_item(w_in, DM, D_IN, N_IN, WIN, 0, nullptr, scr, r, lane); continue; } r -= I_IN;
            if (r < I_UQ) { transpose_item(w_uq, 256, 768, 768, WUQ, 1, q_g, scr, r, lane); continue; } r -= I_UQ;
            if (r < I_UKV) { transpose_item(w_ukv, 128, 1024, 1024, WUKV, 2, kv_g, scr, r, lane); continue; } r -= I_UKV;
            transpose_item(w_out, DM, DM, DM, WOUT, 3, nullptr, scr, r, lane);
        }
        const int gt = vcu * NTHREADS + tid, NGT = G * NTHREADS;
        for (int i = gt; i < NH * 128 * 128 / 8; i += NGT) {
            const int e = i * 8, tt = (e >> 7) & 127, s0 = e & 127;
            const f32x4 a = *(const f32x4*)(w_sp + e), b = *(const f32x4*)(w_sp + e + 4); f32x4 a2, b2;
#pragma unroll
            for (int j = 0; j < 4; ++j) { a2[j] = (s0 + j <= tt) ? a[j] : 0.f; b2[j] = (s0 + 4 + j <= tt) ? b[j] : 0.f; }
            *(u32x4*)(WSP + e) = pack8(a2, b2);
        }
        for (int i = gt; i < T * DM / 8; i += NGT) {
            const f32x4 a = *(const f32x4*)(x + (size_t)i * 8), b = *(const f32x4*)(x + (size_t)i * 8 + 4);
            *(u32x4*)(XB + (size_t)i * 8) = pack8(a, b);
        }
    }
    SEAM(0);
    if (IN(1)) REP(1) {
        WSPTR(WIN, bf16_t, WS_WIN); bf16_t *XB = WIN + (WS_XB - WS_WIN) / 2, *CQ = WIN + (WS_CQ - WS_WIN) / 2, *CKV = WIN + (WS_CKV - WS_WIN) / 2, *KR = WIN + (WS_KR - WS_WIN) / 2, *SZA = WIN + (WS_SZA - WS_WIN) / 2;
        float *SSQQ = (float*)(WIN + (WS_SSQQ - WS_WIN) / 2), *SSQKV = (float*)(WIN + (WS_SSQKV - WS_WIN) / 2), *VSTAT = (float*)(WIN + (WS_VSTAT - WS_WIN) / 2);
        pg8::Gemm g{XB, WIN, T, N_IN, DM}; pg8::StaticOrder S; S.init(T, N_IN, G, bx);
        EpiInProj E{CQ, CKV, KR, SZA, SSQQ, SSQKV, VSTAT, pos};
        pg8::gemm_phase<EpiInProj, pg8::StaticOrder, true, true>(lds, g, S, E);
    }
    SEAM(1);
    if (IN(2)) REP(2) {
        WSPTR(WIN, bf16_t, WS_WIN); bf16_t *WUQ = WIN + (WS_WUQ - WS_WIN) / 2, *WUKV = WIN + (WS_WUKV - WS_WIN) / 2, *CQ = WIN + (WS_CQ - WS_WIN) / 2, *CKV = WIN + (WS_CKV - WS_WIN) / 2, *QN = WIN + (WS_QN - WS_WIN) / 2, *QR = WIN + (WS_QR - WS_WIN) / 2, *KN = WIN + (WS_KN - WS_WIN) / 2;
        float *SSQQ = (float*)(WIN + (WS_SSQQ - WS_WIN) / 2), *SSQKV = (float*)(WIN + (WS_SSQKV - WS_WIN) / 2);
        { pg8::Gemm g{CQ, WUQ, T, 768, 256}; pg8::StaticOrder S; S.init(T, 768, G, bx);
          EpiQUp E{QN, QR, SSQQ, pos};
          pg8::gemm_phase<EpiQUp, pg8::StaticOrder, true, true>(lds, g, S, E); }
        { pg8::Gemm g{CKV, WUKV, T, 1024, 128}; pg8::StaticOrder S; S.init(T, 1024, G, bx);
          EpiKVUp E{KN, SSQKV};
          pg8::gemm_phase<EpiKVUp, pg8::StaticOrder, true, true>(lds, g, S, E); }
    }
    SEAM(2);
    if (IN(3)) {
        const float *sgu_g = args.in[7], *sgu_b = args.in[8], *b_sp = args.in[10];
        WSPTR(WIN, bf16_t, WS_WIN); bf16_t *WSP = WIN + (WS_WSP - WS_WIN) / 2, *KR = WIN + (WS_KR - WS_WIN) / 2, *SZA = WIN + (WS_SZA - WS_WIN) / 2, *GU = WIN + (WS_GU - WS_WIN) / 2, *GV = WIN + (WS_GV - WS_WIN) / 2, *SZB = WIN + (WS_SZB - WS_WIN) / 2,
            *QN = WIN + (WS_QN - WS_WIN) / 2, *QR = WIN + (WS_QR - WS_WIN) / 2, *KN = WIN + (WS_KN - WS_WIN) / 2, *VV = WIN + (WS_VV - WS_WIN) / 2, *MG = WIN + (WS_MG - WS_WIN) / 2;
        float* VSTAT = (float*)(WIN + (WS_VSTAT - WS_WIN) / 2);
        const AttT A{QN, QR, KN, KR, VV, SZA, MG};
        REP(3) for (int idx = vcu; idx < BATCH * NH * 32; idx += G) {
            const int i = idx >> 8, v = idx & 255, bh = v >> 3, s = v & 7;
            const int qb = (i == 0) ? s : (i == 1) ? 15 - s : (i == 2) ? 16 + s : 31 - s;
            attn_unit(bh >> 3, bh & 7, qb, A, lds);
        }
        const SguT Sg{GV, GU, SZB, WSP, VSTAT, sgu_g, sgu_b, b_sp, MG};
        REP(6) for (int idx = vcu; idx < (T / 128) * NH; idx += G) sgu_unit(idx >> 3, idx & 7, Sg, lds);
    }
    SEAM(3);
    if (IN(4)) REP(4) {
        WSPTR(WIN, bf16_t, WS_WIN); bf16_t *WOUT = WIN + (WS_WOUT - WS_WIN) / 2, *MG = WIN + (WS_MG - WS_WIN) / 2;
        pg8::Gemm g{MG, WOUT, T, DM, DM}; pg8::StaticOrder S; S.init(T, DM, G, bx);
        EpiOut E{x, args.out};
        pg8::gemm_phase<EpiOut, pg8::StaticOrder, true, true>(lds, g, S, E);
    }
    SEAM(4);
    if (IN(5)) REP(5) {
        const float *ln_g = args.in[12], *ln_b = args.in[13];
        int tid = threadIdx.x; asm volatile("" : "+v"(tid)); const int lane = tid & 63, wave = __builtin_amdgcn_readfirstlane(tid >> 6);
        const int gw = vcu * NWAVES + wave, NGW = G * NWAVES;
        f32x4 gg[4], bb[4];
#pragma unroll
        for (int j = 0; j < 4; ++j) { gg[j] = *(const f32x4*)(ln_g + 4 * lane + 256 * j); bb[j] = *(const f32x4*)(ln_b + 4 * lane + 256 * j); }
        for (int m = gw; m < T; m += NGW) {
            f32x4* rowp = (f32x4*)(args.out + (size_t)m * DM) + lane;
            f32x4 v[4]; float s = 0.f;
#pragma unroll
            for (int j = 0; j < 4; ++j) { v[j] = rowp[64 * j]; s += sum4(v[j]); }
            const float mean = wave_sum(s) * (1.f / DM); float s2 = 0.f;
#pragma unroll
            for (int j = 0; j < 4; ++j) { v[j] = v[j] - mean; s2 += ssq4(v[j]); }
            const float rstd = 1.f / sqrtf(wave_sum(s2) * (1.f / DM) + EPS);
#pragma unroll
            for (int j = 0; j < 4; ++j) rowp[64 * j] = v[j] * rstd * gg[j] + bb[j];
        }
    }
#undef IN
#undef SEAM
}
}

extern "C" void kernel_launch(void* const* d_in, const int* in_sizes, int n_in, void* d_out, int out_size, void* d_ws, size_t ws_size, hipStream_t stream) {
    using namespace mk;
    static int grid = 0;
    if (grid == 0) {
        if (n_in != 14 || in_sizes[0] != T * DM || out_size != T * DM || ws_size < WS_END) {
            fprintf(stderr, "kernel_launch: unexpected problem (n_in %d, in0 %d, out %d, ws %zu)\n", n_in, n_in > 0 ? in_sizes[0] : -1, out_size, ws_size); grid = -1; return; }
        int dev = 0, cus = 0, per_cu = 0;
        if (hipGetDevice(&dev) != hipSuccess || hipDeviceGetAttribute(&cus, hipDeviceAttributeMultiprocessorCount, dev) != hipSuccess) { grid = -1; return; }
        if (hipFuncSetAttribute((const void*)mk_fwd, hipFuncAttributeMaxDynamicSharedMemorySize, LDS_BYTES) != hipSuccess) { fprintf(stderr, "kernel_launch: hipFuncSetAttribute failed\n"); grid = -1; return; }
        if (hipOccupancyMaxActiveBlocksPerMultiprocessor(&per_cu, (const void*)mk_fwd, NTHREADS, LDS_BYTES) != hipSuccess || per_cu < 1) {
            fprintf(stderr, "kernel_launch: occupancy query reports %d workgroups per CU\n", per_cu); (void)hipGetLastError(); grid = -1; return; }
        grid = cus;
    }
    if (grid < 0) return;
    if (hipMemsetAsync((char*)d_ws + WS_BAR, 0, BAR_BYTES, stream) != hipSuccess) { fprintf(stderr, "kernel_launch: memset failed\n"); return; }
    Args a{};
    for (int i = 0; i < 14; ++i) a.in[i] = (const float*)d_in[i];
    a.out = (float*)d_out; a.ws = (unsigned char*)d_ws;
#if MK_SPLIT
    for (int p = 0; p < 6; ++p) { a.ph_lo = p; a.ph_hi = p + 1; hipLaunchKernelGGL(mk_fwd, dim3(grid), dim3(NTHREADS), LDS_BYTES, stream, a); }
#else
    a.ph_lo = 0; a.ph_hi = 6;
    void* kargs[] = {&a};
    const hipError_t e = hipLaunchCooperativeKernel((const void*)mk_fwd, dim3(grid), dim3(NTHREADS), kargs, LDS_BYTES, stream);
    if (e != hipSuccess) fprintf(stderr, "kernel_launch: cooperative launch failed: %s (grid %d)\n", hipGetErrorString(e), grid);
#endif
}
```

```cpp
#include <hip/hip_runtime.h>
#include <hip/hip_cooperative_groups.h>
#include <cstdio>
#include <cstdint>
namespace cg = cooperative_groups;
namespace pg8 {
#define PG8_LAS __attribute__((address_space(3)))
typedef unsigned short bf16_t;
typedef short bf16x8 __attribute__((ext_vector_type(8)));
typedef float f32x4 __attribute__((ext_vector_type(4)));
typedef unsigned u32x4 __attribute__((ext_vector_type(4)));
constexpr int BM = 256, BK = 64, HALF = 128, HTB = HALF * BK * 2  , STAGE_BYTES = 8 * HTB, NXCD = 8, WGM = 8;

__host__ __device__ __forceinline__ int lds_byte(int r, int c) { const int st = (r >> 4) * 2 + (c >> 5), rr = r & 15, cc = c & 31, ob = rr * 64 + cc * 2; return st * 1024 + (ob ^ (((ob >> 9) & 1) << 5)); }
__host__ __device__ __forceinline__ void stage_rc(int b, int& R, int& C) { const int st = b / 1024, sb = b % 1024, swz = sb ^ (((sb >> 9) & 1) << 5); R = (st >> 1) * 16 + swz / 64; C = (st & 1) * 32 + (swz % 64) / 2; }
__host__ __device__ __forceinline__ int perm32(int rho) { const int n = rho >> 4, i = rho & 15; return 8 * (i >> 2) + 4 * n + (i & 3); }

struct Unit { int pm, pn; };
struct Gemm { const bf16_t* A; const bf16_t* Bt; int M, N, K; };

struct StaticOrder {
    int nM, nN, nwg, G, c;
    __host__ __device__ void init(int M, int N, int G_, int c_) { nM = M / BM; nN = N / BM; nwg = nM * nN; G = G_; c = c_; }
    __host__ __device__ bool next(int i, Unit& u) const {
        const long L = (long)i * G + c; if (L >= nwg) return false;
        int wgid = (int)L; { const int q = nwg / NXCD, r = nwg % NXCD, xcd = wgid % NXCD, off = wgid / NXCD; wgid = (xcd < r ? xcd * (q + 1) : r * (q + 1) + (xcd - r) * q) + off; }
        const int nig = WGM * nN, gid = wgid / nig, fm = gid * WGM, gsz = (nM - fm) < WGM ? (nM - fm) : WGM;
        u.pm = fm + ((wgid % nig) % gsz); u.pn = (wgid % nig) / gsz; return true;
    }
    __device__ __forceinline__ void a_ready(const Unit&) const {}
    __device__ __forceinline__ void done(const Unit&) const {}
};

__device__ __forceinline__ unsigned cvt_pk_bf16(float lo, float hi) { unsigned r; asm volatile("v_cvt_pk_bf16_f32 %0, %1, %2" : "=v"(r) : "v"(lo), "v"(hi)); return r; }
typedef float f32x2 __attribute__((ext_vector_type(2)));
__device__ __forceinline__ f32x2 gelu_pk(f32x2 v) {
    const f32x2 av = __builtin_elementwise_abs(v), d = av * 0.2316418882f + 1.0f;
    f32x2 t; t.x = __builtin_amdgcn_rcpf(d.x); t.y = __builtin_amdgcn_rcpf(d.y);
    f32x2 q = t * 0.5307027145f + (-0.7265760135f); q = q * t + 0.7107068705f; q = q * t + (-0.142248368f); q = q * t + 0.127414796f; q = q * t;
    const f32x2 s = (v * v) * (-0.72134752044f);
    f32x2 e; e.x = __builtin_amdgcn_exp2f(s.x); e.y = __builtin_amdgcn_exp2f(s.y);
    const f32x2 m = v * (q * e), r = v - m;
    f32x2 o; o.x = v.x < 0.f ? m.x : r.x; o.y = v.y < 0.f ? m.y : r.y; return o;
}

template <int ACT  > struct EpiBf16 {
    static constexpr bool PERM = true, AFTER_DRAIN = false; static_assert(ACT == 0 || ACT == 1, "EpiBf16: ACT is 0 (none) or 1 (gelu_pk)");
    bf16_t* O; int ldc; const float* bias; int split_cols; size_t split_stride; float scale0;
    __device__ __forceinline__ void operator()(const f32x4 (&acc)[2][2][4][2], const Unit& u, int wr, int wc, int fr, int fq) const {
        const int row0 = u.pm * BM + wr * 64 + fr; int colt = u.pn * BM; bf16_t* base = O;
        float sc = 1.f; if (split_cols) { const int t = colt / split_cols; base += (size_t)t * split_stride; colt -= t * split_cols; if (t == 0) sc = scale0; }
        const int col0 = colt + wc * 32 + 8 * fq, bcol0 = u.pn * BM + wc * 32 + 8 * fq;
        f32x4 bv[2][2];
#pragma unroll
        for (int bj = 0; bj < 2; ++bj)
#pragma unroll
            for (int n = 0; n < 2; ++n) bv[bj][n] = bias ? *(const f32x4*)(bias + bcol0 + bj * HALF + 4 * n) : (f32x4){0.f, 0.f, 0.f, 0.f};
#pragma unroll
        for (int ai = 0; ai < 2; ++ai)
#pragma unroll
            for (int m = 0; m < 4; ++m) { bf16_t* rowp = base + (size_t)(row0 + ai * HALF + m * 16) * ldc + col0;
#pragma unroll
                for (int bj = 0; bj < 2; ++bj) { f32x4 v0 = acc[ai][bj][m][0] + bv[bj][0], v1 = acc[ai][bj][m][1] + bv[bj][1];
                    if (ACT == 1) { f32x2 a = gelu_pk((f32x2){v0[0], v0[1]}), b = gelu_pk((f32x2){v0[2], v0[3]}), c = gelu_pk((f32x2){v1[0], v1[1]}), d = gelu_pk((f32x2){v1[2], v1[3]});
                        v0 = (f32x4){a.x, a.y, b.x, b.y}; v1 = (f32x4){c.x, c.y, d.x, d.y}; }
                    v0 = v0 * sc; v1 = v1 * sc; u32x4 w; w.x = cvt_pk_bf16(v0[0], v0[1]); w.y = cvt_pk_bf16(v0[2], v0[3]); w.z = cvt_pk_bf16(v1[0], v1[1]); w.w = cvt_pk_bf16(v1[2], v1[3]);
                    *(u32x4*)(rowp + bj * HALF) = w; } }
    }
};
template <class Epi, class Sched, bool ALIGN_EPI = false, bool SP2 = false>
__device__ __forceinline__ void gemm_phase(PG8_LAS unsigned char* lds, const Gemm g, const Sched& S, const Epi& E) {
    int tid_ = threadIdx.x; asm volatile("" : "+v"(tid_));
    const int tid = tid_, wid = __builtin_amdgcn_readfirstlane(tid >> 6), lane = tid & 63, wr = wid >> 2, wc = wid & 3, fr = lane & 15, fq = lane >> 4;
    const int K = g.K, nt = K / BK;
    unsigned voffA[2], voffB[2];
#pragma unroll
    for (int i = 0; i < 2; ++i) { int R, C; stage_rc(tid * 16 + i * 8192, R, C); const int Rb = Epi::PERM ? ((R & ~31) + perm32(R & 31)) : R;
        voffA[i] = (unsigned)(R * K + C) * 2u; voffB[i] = (unsigned)(Rb * K + C) * 2u; }
    const size_t kstep = (size_t)(BK * 2);
    const size_t hstep = (size_t)HALF * K * 2;
    const size_t tstep = 2 * hstep;
    const unsigned ldsw = (unsigned)wid * 1024u;
    const int aoff = lds_byte(wr * 64 + fr, fq * 8), boff = lds_byte(wc * 32 + fr, fq * 8);
#define PG8_SA(b, h) (((b) * 2 + (h)) * HTB)
#define PG8_SB(b, h) ((4 + (b) * 2 + (h)) * HTB)
#define PG8_STAGE(bufoff, gbase, voff) do { _Pragma("unroll") for (int _i = 0; _i < 2; ++_i) \
        __builtin_amdgcn_global_load_lds((const unsigned*)((const char*)(gbase) + (voff)[_i]), (PG8_LAS unsigned*)(lds + (bufoff) + ldsw + _i * 8192), 16, 0, 0); } while (0)
#define PG8_LDA(dst, b, h) do { _Pragma("unroll") for (int m = 0; m < 4; ++m) _Pragma("unroll") for (int k = 0; k < 2; ++k) dst[m][k] = *(const PG8_LAS bf16x8*)(lds + PG8_SA(b, h) + aoff + m * 2048 + k * 1024); } while (0)
#define PG8_LDB(dst, b, h) do { _Pragma("unroll") for (int n = 0; n < 2; ++n) _Pragma("unroll") for (int k = 0; k < 2; ++k) dst[n][k] = *(const PG8_LAS bf16x8*)(lds + PG8_SB(b, h) + boff + n * 2048 + k * 1024); } while (0)
#define PG8_MMA(ai, bj, At, Bt) do { __builtin_amdgcn_s_setprio(1); _Pragma("unroll") for (int m = 0; m < 4; ++m) _Pragma("unroll") for (int n = 0; n < 2; ++n) _Pragma("unroll") for (int k = 0; k < 2; ++k) \
        acc[ai][bj][m][n] = __builtin_amdgcn_mfma_f32_16x16x32_bf16(Bt[n][k], At[m][k], acc[ai][bj][m][n], 0, 0, 0); __builtin_amdgcn_s_setprio(0); } while (0)
#define PG8_WAIT_V(n) asm volatile("s_waitcnt vmcnt(" #n ")" ::: "memory")
#define PG8_WAIT_L(n) asm volatile("s_waitcnt lgkmcnt(" #n ")" ::: "memory")
#define PG8_BAR __builtin_amdgcn_s_barrier()
#define PG8_SCHED __builtin_amdgcn_sched_barrier(0)
    Unit cur, nxt; int ui = 0;
    if (!S.next(0, cur)) return;
    f32x4 acc[2][2][4][2];
#pragma unroll
    for (int a = 0; a < 2; ++a)
#pragma unroll
        for (int b = 0; b < 2; ++b)
#pragma unroll
            for (int m = 0; m < 4; ++m)
#pragma unroll
                for (int n = 0; n < 2; ++n) acc[a][b][m][n] = (f32x4){0.f, 0.f, 0.f, 0.f};
    bf16x8 At[4][2], B0[2][2], B1[2][2];
    const char* cA = (const char*)g.A + (size_t)cur.pm * tstep; const char* cB = (const char*)g.Bt + (size_t)cur.pn * tstep;
    S.a_ready(cur);
    if constexpr (SP2) {
        PG8_STAGE(PG8_SB(0, 0), cB, voffB); PG8_STAGE(PG8_SB(0, 1), cB + hstep, voffB); PG8_STAGE(PG8_SA(0, 0), cA, voffA); PG8_STAGE(PG8_SA(0, 1), cA + hstep, voffA);
        if (wr == 1) PG8_BAR;
        PG8_WAIT_V(2); PG8_BAR;
        PG8_STAGE(PG8_SB(1, 0), cB + kstep, voffB); PG8_STAGE(PG8_SA(1, 0), cA + kstep, voffA); PG8_STAGE(PG8_SB(1, 1), cB + hstep + kstep, voffB);
        PG8_WAIT_V(6); PG8_BAR;
    } else {
        PG8_STAGE(PG8_SB(0, 0), cB, voffB); PG8_STAGE(PG8_SA(0, 0), cA, voffA); PG8_STAGE(PG8_SB(0, 1), cB + hstep, voffB); PG8_STAGE(PG8_SA(0, 1), cA + hstep, voffA);
        if (wr == 1) PG8_BAR;
        PG8_WAIT_V(4); PG8_BAR;
        PG8_STAGE(PG8_SB(1, 0), cB + kstep, voffB); PG8_STAGE(PG8_SA(1, 0), cA + kstep, voffA); PG8_STAGE(PG8_SB(1, 1), cB + hstep + kstep, voffB);
        PG8_WAIT_V(6); PG8_BAR;
    }
    for (;;) {
        const bool has_next = S.next(ui + 1, nxt);
        const char* nA = has_next ? (const char*)g.A + (size_t)nxt.pm * tstep : cA; const char* nB = has_next ? (const char*)g.Bt + (size_t)nxt.pn * tstep : cB;
        for (int t = 0; t < nt; t += 2) {
            const bool last = (t == nt - 2);
            const char* a1 = cA + (size_t)(t + 1) * kstep;
            const char* a2 = last ? nA : cA + (size_t)(t + 2) * kstep; const char* b2 = last ? nB : cB + (size_t)(t + 2) * kstep;
            const char* a3 = a2 + kstep; const char* b3 = b2 + kstep;
            if (last && has_next) S.a_ready(nxt);
            if constexpr (SP2) {
            PG8_LDB(B0, 0, 0); PG8_LDB(B1, 0, 1); PG8_SCHED; PG8_LDA(At, 0, 0); PG8_STAGE(PG8_SA(1, 1), a1 + hstep, voffA);
            PG8_WAIT_V(8); PG8_WAIT_L(0); PG8_BAR; PG8_MMA(0, 0, At, B0); PG8_MMA(0, 1, At, B1); PG8_BAR; PG8_SCHED;
            PG8_LDA(At, 0, 1); PG8_STAGE(PG8_SB(0, 0), b2, voffB); PG8_STAGE(PG8_SB(0, 1), b2 + hstep, voffB); PG8_STAGE(PG8_SA(0, 0), a2, voffA);
            PG8_WAIT_V(8); PG8_WAIT_L(0); PG8_BAR; PG8_MMA(1, 0, At, B0); PG8_MMA(1, 1, At, B1); PG8_BAR; PG8_SCHED;
            PG8_LDB(B0, 1, 0); PG8_LDB(B1, 1, 1); PG8_SCHED; PG8_LDA(At, 1, 0); PG8_STAGE(PG8_SA(0, 1), a2 + hstep, voffA);
            PG8_WAIT_V(8); PG8_WAIT_L(0); PG8_BAR; PG8_MMA(0, 0, At, B0); PG8_MMA(0, 1, At, B1); PG8_BAR; PG8_SCHED;
            PG8_LDA(At, 1, 1); PG8_STAGE(PG8_SB(1, 0), b3, voffB); PG8_STAGE(PG8_SB(1, 1), b3 + hstep, voffB); PG8_STAGE(PG8_SA(1, 0), a3, voffA);
            PG8_WAIT_V(8); PG8_WAIT_L(0); PG8_BAR; PG8_MMA(1, 0, At, B0); PG8_MMA(1, 1, At, B1); PG8_BAR; PG8_SCHED;
            } else {
            PG8_LDB(B0, 0, 0); PG8_SCHED; PG8_LDA(At, 0, 0); PG8_STAGE(PG8_SA(1, 1), a1 + hstep, voffA);
            PG8_WAIT_L(8); PG8_BAR; PG8_WAIT_L(0); PG8_MMA(0, 0, At, B0); PG8_BAR; PG8_SCHED;
            PG8_LDB(B1, 0, 1); PG8_STAGE(PG8_SB(0, 0), b2, voffB);
            PG8_BAR; PG8_WAIT_L(0); PG8_MMA(0, 1, At, B1); PG8_BAR;
            PG8_LDA(At, 0, 1); PG8_STAGE(PG8_SA(0, 0), a2, voffA);
            PG8_BAR; PG8_WAIT_L(0); PG8_MMA(1, 0, At, B0); PG8_BAR; PG8_SCHED;
            PG8_STAGE(PG8_SB(0, 1), b2 + hstep, voffB);
            PG8_WAIT_V(6); PG8_BAR; PG8_MMA(1, 1, At, B1); PG8_BAR;
            PG8_LDB(B0, 1, 0); PG8_SCHED; PG8_LDA(At, 1, 0); PG8_STAGE(PG8_SA(0, 1), a2 + hstep, voffA);
            PG8_WAIT_L(8); PG8_BAR; PG8_WAIT_L(0); PG8_MMA(0, 0, At, B0); PG8_BAR; PG8_SCHED;
            PG8_LDB(B1, 1, 1); PG8_STAGE(PG8_SB(1, 0), b3, voffB);
            PG8_BAR; PG8_WAIT_L(0); PG8_MMA(0, 1, At, B1); PG8_BAR;
            PG8_LDA(At, 1, 1); PG8_STAGE(PG8_SA(1, 0), a3, voffA);
            PG8_BAR; PG8_WAIT_L(0); PG8_MMA(1, 0, At, B0); PG8_BAR; PG8_SCHED;
            PG8_STAGE(PG8_SB(1, 1), b3 + hstep, voffB);
            PG8_WAIT_V(6); PG8_BAR; PG8_MMA(1, 1, At, B1); PG8_BAR;
            }
        }
        if constexpr (ALIGN_EPI) { if (wr == 0) PG8_BAR; }
        if constexpr (!Epi::AFTER_DRAIN) { E(acc, cur, wr, wc, fr, fq); S.done(cur); }
        if (!has_next) break;
#pragma unroll
        for (int a = 0; a < 2; ++a)
#pragma unroll
            for (int b = 0; b < 2; ++b)
#pragma unroll
                for (int m = 0; m < 4; ++m)
#pragma unroll
                    for (int n = 0; n < 2; ++n) acc[a][b][m][n] = (f32x4){0.f, 0.f, 0.f, 0.f};
        cur = nxt; cA = nA; cB = nB; ++ui;
        if constexpr (ALIGN_EPI) { if (wr == 1) PG8_BAR; }
    }
    PG8_WAIT_V(0);
    if constexpr (!ALIGN_EPI) { if (wr == 0) PG8_BAR; }
    PG8_BAR;
    if constexpr (Epi::AFTER_DRAIN) { E.fused(acc, cur, wr, wc, fr, fq, lds, wid, lane); S.done(cur); }
#undef PG8_SA
#undef PG8_SB
#undef PG8_STAGE
#undef PG8_LDA
#undef PG8_LDB
#undef PG8_MMA
#undef PG8_WAIT_V
#undef PG8_WAIT_L
#undef PG8_BAR
#undef PG8_SCHED
}
}
#ifndef MK_SPLIT
#define MK_SPLIT 0
#endif
namespace mk {
#define LAS __attribute__((address_space(3)))
#define GAS __attribute__((address_space(1)))
typedef unsigned short bf16_t;
typedef short bf16x8 __attribute__((ext_vector_type(8)));
typedef short s16x4 __attribute__((ext_vector_type(4)));
typedef float f32x4 __attribute__((ext_vector_type(4)));
typedef float f32x2 __attribute__((ext_vector_type(2)));
typedef float f32x16 __attribute__((ext_vector_type(16)));
typedef unsigned u32x4 __attribute__((ext_vector_type(4)));
typedef unsigned u32x2 __attribute__((ext_vector_type(2)));
using pg8::Unit;

constexpr int BATCH = 4, SEQ = 8192, DM = 1024, T = BATCH * SEQ, NH = 8;
constexpr int D_IN = 2464, N_IN = 2560;
constexpr float EPS = 1e-5f;
constexpr float DN_ALPHA = 1.189207115002721f;
constexpr float QSCALE = 0.10206207261596575f * 1.4426950408889634f;
constexpr int NWAVES = 8, NTHREADS = 512;

constexpr size_t MiB = 1u << 20;
constexpr size_t WS_WIN = 2 * MiB, WS_WUQ = 8 * MiB, WS_WUKV = 9 * MiB, WS_WOUT = 10 * MiB, WS_WSP = 12 * MiB;
constexpr size_t WS_SSQQ = 13 * MiB, WS_SSQKV = 13 * MiB + 512 * 1024, WS_VSTAT = 14 * MiB;
constexpr size_t WS_XB = 32 * MiB, WS_CQ = 96 * MiB, WS_CKV = 112 * MiB, WS_KR = 120 * MiB;
constexpr size_t WS_SZA = 128 * MiB, WS_GU = 160 * MiB, WS_GV = 192 * MiB, WS_SZB = 224 * MiB;
constexpr size_t WS_QN = 256 * MiB, WS_QR = 288 * MiB, WS_KN = 304 * MiB, WS_VV = 336 * MiB, WS_MG = 368 * MiB, WS_END = 432 * MiB;

constexpr size_t WS_BAR = 0, BAR_BYTES = 16384;
constexpr int LDS_MISC = 131072 + 320;
constexpr int LDS_BYTES = 147456;

__device__ const float INVF[16] = {1.0f, 0.5623413324356079f, 0.3162277638912201f, 0.17782793939113617f, 0.10000000149011612f, 0.05623412877321243f,
    0.03162277862429619f, 0.017782794311642647f, 0.009999999776482582f, 0.005623413249850273f, 0.003162277862429619f, 0.0017782794311642647f,
    0.0010000000474974513f, 0.000562341301701963f, 0.0003162277862429619f, 0.00017782794020604342f};

__device__ __forceinline__ unsigned cvt2(float lo, float hi) { return pg8::cvt_pk_bf16(lo, hi); }
__device__ __forceinline__ u32x4 pack8(const f32x4 a, const f32x4 b) { u32x4 w; w.x = cvt2(a[0], a[1]); w.y = cvt2(a[2], a[3]); w.z = cvt2(b[0], b[1]); w.w = cvt2(b[2], b[3]); return w; }
__device__ __forceinline__ u32x2 pack4(const f32x4 a) { u32x2 w; w.x = cvt2(a[0], a[1]); w.y = cvt2(a[2], a[3]); return w; }
__device__ __forceinline__ float bf_lo(unsigned u) { return __uint_as_float(u << 16); }
__device__ __forceinline__ float bf_hi(unsigned u) { return __uint_as_float(u & 0xffff0000u); }
__device__ __forceinline__ f32x4 unpack4(const u32x2 w) { return (f32x4){bf_lo(w.x), bf_hi(w.x), bf_lo(w.y), bf_hi(w.y)}; }
__device__ __forceinline__ float silu_f(float x) { return x / (1.f + __expf(-x)); }
__device__ __forceinline__ f32x4 silu4(const f32x4 v) { return (f32x4){silu_f(v[0]), silu_f(v[1]), silu_f(v[2]), silu_f(v[3])}; }
__device__ __forceinline__ f32x4 gelu4(const f32x4 v) { const f32x2 a = pg8::gelu_pk((f32x2){v[0], v[1]}), b = pg8::gelu_pk((f32x2){v[2], v[3]}); return (f32x4){a.x, a.y, b.x, b.y}; }
__device__ __forceinline__ float sum4(const f32x4 v) { return (v[0] + v[1]) + (v[2] + v[3]); }
__device__ __forceinline__ float ssq4(const f32x4 v) { return (v[0] * v[0] + v[1] * v[1]) + (v[2] * v[2] + v[3] * v[3]); }
__device__ __forceinline__ float quad_sum(float s) { s += __shfl_xor(s, 16); s += __shfl_xor(s, 32); return s; }
__device__ __forceinline__ float wave_sum(float v) {
#pragma unroll
    for (int o = 1; o < 64; o <<= 1) v += __shfl_xor(v, o);
    return v;
}
__device__ __forceinline__ void rope4(const f32x4 t1, const f32x4 t2, int pos, int fq, f32x4& o1, f32x4& o2) {
    const float pf = (float)pos;
#pragma unroll
    for (int e = 0; e < 4; ++e) {
        const float ang = pf * INVF[4 * fq + e];
        const double x = (double)ang * 0.15915494309189535;
        const float fr = (float)(x - __builtin_rint(x));
        const float s = __builtin_amdgcn_sinf(fr), c = __builtin_amdgcn_cosf(fr);
        o1[e] = t1[e] * c - t2[e] * s; o2[e] = t1[e] * s + t2[e] * c;
    }
}

struct EpiInProj {
    static constexpr bool PERM = true, AFTER_DRAIN = false;
    bf16_t *CQ, *CKV, *KR, *ACT; GAS float *SSQQ, *SSQKV, *VSTAT; const GAS int* pos;
    __device__ __forceinline__ void operator()(const f32x4 (&acc)[2][2][4][2], const Unit& u, int wr, int wc, int fr, int fq) const {
        asm volatile("" : "+v"(fr), "+v"(fq));
        const int pn = u.pn, row0 = u.pm * 256 + wr * 64 + fr, cw = wc * 32 + 8 * fq;
        if (pn == 0) {
#pragma unroll
            for (int ai = 0; ai < 2; ++ai)
#pragma unroll
                for (int m = 0; m < 4; ++m) { const size_t row = row0 + ai * 128 + m * 16; float ss = 0.f;
#pragma unroll
                    for (int bj = 0; bj < 2; ++bj) { const f32x4 v0 = acc[ai][bj][m][0], v1 = acc[ai][bj][m][1]; ss += ssq4(v0) + ssq4(v1);
                        *(GAS u32x4*)(CQ + row * 256 + bj * 128 + cw) = pack8(v0, v1); }
                    ss = quad_sum(ss); if (fq == 0) SSQQ[row * 4 + wc] = ss; }
        } else if (pn == 1) {
#pragma unroll
            for (int ai = 0; ai < 2; ++ai)
#pragma unroll
                for (int m = 0; m < 4; ++m) { const size_t row = row0 + ai * 128 + m * 16;
                    const f32x4 v0 = acc[ai][0][m][0], v1 = acc[ai][0][m][1]; float ss = ssq4(v0) + ssq4(v1);
                    *(GAS u32x4*)(CKV + row * 128 + cw) = pack8(v0, v1);
                    ss = quad_sum(ss); if (fq == 0) SSQKV[row * 4 + wc] = ss;
                    if (wc == 0) { f32x4 o1, o2; rope4(acc[ai][1][m][0], acc[ai][1][m][1], pos[row], fq, o1, o2);
                        *(GAS u32x2*)(KR + row * 32 + 4 * fq) = pack4(o1); *(GAS u32x2*)(KR + row * 32 + 16 + 4 * fq) = pack4(o2); } }
        } else {
            const int seg = (pn - 2) >> 1, half = (pn - 2) & 1;
            bf16_t* dst = ACT + (size_t)seg * (16u << 20);
            const bool is_gelu = (seg == 1 || seg == 2);
#pragma unroll
            for (int ai = 0; ai < 2; ++ai)
#pragma unroll
                for (int m = 0; m < 4; ++m) { const size_t row = row0 + ai * 128 + m * 16; float s1 = 0.f, s2 = 0.f;
#pragma unroll
                    for (int bj = 0; bj < 2; ++bj) { f32x4 v0 = acc[ai][bj][m][0], v1 = acc[ai][bj][m][1];
                        if (is_gelu) { v0 = gelu4(v0); v1 = gelu4(v1); } else { v0 = silu4(v0); v1 = silu4(v1); }
                        s1 += sum4(v0) + sum4(v1); s2 += ssq4(v0) + ssq4(v1);
                        *(GAS u32x4*)(dst + row * 512 + half * 256 + bj * 128 + cw) = pack8(v0, v1); }
                    if (seg == 2) { s1 = quad_sum(s1); s2 = quad_sum(s2); if (fq == 0) *(GAS f32x2*)(VSTAT + (row * 8 + half * 4 + wc) * 2) = (f32x2){s1, s2}; } }
        }
    }
};
struct EpiQUp {
    static constexpr bool PERM = true, AFTER_DRAIN = false;
    bf16_t *QN, *QR; const GAS float* SSQQ; const GAS int* pos;
    __device__ __forceinline__ void operator()(const f32x4 (&acc)[2][2][4][2], const Unit& u, int wr, int wc, int fr, int fq) const {
        asm volatile("" : "+v"(fr), "+v"(fq));
        const int pn = u.pn, row0 = u.pm * 256 + wr * 64 + fr, cw = wc * 32 + 8 * fq;
#pragma unroll
        for (int ai = 0; ai < 2; ++ai)
#pragma unroll
            for (int m = 0; m < 4; ++m) { const size_t row = row0 + ai * 128 + m * 16;
                const f32x4 sq = *(const GAS f32x4*)(SSQQ + row * 4);
                const float sc = QSCALE / sqrtf(sum4(sq) * (1.f / 256.f) + EPS);
                if (pn < 2) {
#pragma unroll
                    for (int bj = 0; bj < 2; ++bj) *(GAS u32x4*)(QN + row * 512 + pn * 256 + bj * 128 + cw) = pack8(acc[ai][bj][m][0] * sc, acc[ai][bj][m][1] * sc);
                } else { const int p = pos[row];
#pragma unroll
                    for (int bj = 0; bj < 2; ++bj) { const int head = bj * 4 + wc; f32x4 o1, o2; rope4(acc[ai][bj][m][0] * sc, acc[ai][bj][m][1] * sc, p, fq, o1, o2);
                        *(GAS u32x2*)(QR + row * 256 + head * 32 + 4 * fq) = pack4(o1); *(GAS u32x2*)(QR + row * 256 + head * 32 + 16 + 4 * fq) = pack4(o2); asm volatile("" ::: "memory"); } }
                asm volatile("" ::: "memory");
            }
    }
};
struct EpiKVUp {
    static constexpr bool PERM = true, AFTER_DRAIN = false;
    bf16_t *KN; const GAS float* SSQKV;
    __device__ __forceinline__ void operator()(const f32x4 (&acc)[2][2][4][2], const Unit& u, int wr, int wc, int fr, int fq) const {
        asm volatile("" : "+v"(fr), "+v"(fq));
        const int pn = u.pn, row0 = u.pm * 256 + wr * 64 + fr, cw = wc * 32 + 8 * fq;
        bf16_t* dst = KN + (size_t)(pn >> 1) * (16u << 20) + (pn & 1) * 256;
#pragma unroll
        for (int ai = 0; ai < 2; ++ai)
#pragma unroll
            for (int m = 0; m < 4; ++m) { const size_t row = row0 + ai * 128 + m * 16;
                const f32x4 sq = *(const GAS f32x4*)(SSQKV + row * 4);
                const float sc = 1.f / sqrtf(sum4(sq) * (1.f / 128.f) + EPS);
#pragma unroll
                for (int bj = 0; bj < 2; ++bj) *(GAS u32x4*)(dst + row * 512 + bj * 128 + cw) = pack8(acc[ai][bj][m][0] * sc, acc[ai][bj][m][1] * sc); }
    }
};
struct EpiOut {
    static constexpr bool PERM = true, AFTER_DRAIN = false;
    const float* x; float* out;
    __device__ __forceinline__ void operator()(const f32x4 (&acc)[2][2][4][2], const Unit& u, int wr, int wc, int fr, int fq) const {
        asm volatile("" : "+v"(fr), "+v"(fq));
        const int row0 = u.pm * 256 + wr * 64 + fr, col0 = u.pn * 256 + wc * 32 + 8 * fq;
#pragma unroll
        for (int ai = 0; ai < 2; ++ai)
#pragma unroll
            for (int m = 0; m < 4; ++m) { const size_t off = (size_t)(row0 + ai * 128 + m * 16) * DM + col0;
#pragma unroll
                for (int bj = 0; bj < 2; ++bj) { const f32x4 x0 = *(const GAS f32x4*)(x + off + bj * 128), x1 = *(const GAS f32x4*)(x + off + bj * 128 + 4);
                    *(GAS f32x4*)(out + off + bj * 128) = x0 * DN_ALPHA + acc[ai][bj][m][0]; *(GAS f32x4*)(out + off + bj * 128 + 4) = x1 * DN_ALPHA + acc[ai][bj][m][1]; } }
    }
};

__device__ __forceinline__ int rope_perm(int pp) { const int fq = pp >> 3, j = pp & 7; return (j < 4) ? 4 * fq + j : 16 + 4 * fq + (j - 4); }
__device__ __forceinline__ int src_col(int kind, int n) {
    if (kind == 0) {
        if (n < 384) return n; if (n < 416) return 384 + rope_perm(n - 384); if (n < 512) return -1; return n - 96;
    } else if (kind == 1) {
        if (n < 512) return (n >> 6) * 96 + (n & 63); const int p = n - 512; return (p >> 5) * 96 + 64 + rope_perm(p & 31);
    } else if (kind == 2) {
        if (n < 512) return (n >> 6) * 128 + (n & 63); const int p = n - 512; return (p >> 6) * 128 + 64 + (p & 63);
    }
    return n;
}
__device__ __forceinline__ void transpose_item(const GAS float* W, int K, int Nsrc, int Ndst, bf16_t* WT, int kind, const GAS float* kscale, LAS float* scr, int item, int lane) {
    const int nblk = Ndst / 32, kb = item / nblk, nb = item % nblk, k0 = 64 * kb, n0 = 32 * nb;
    const int sc = src_col(kind, n0 + (lane & 31));
#pragma unroll 8
    for (int i = 0; i < 32; ++i) { const int kk = 2 * i + (lane >> 5); float v = 0.f;
        if (sc >= 0) { v = W[(size_t)(k0 + kk) * Nsrc + sc]; if (kscale) v *= kscale[k0 + kk]; }
        scr[kk * 33 + (lane & 31)] = v; }
    asm volatile("s_waitcnt lgkmcnt(0)" ::: "memory");
    const int c = lane & 7;
#pragma unroll
    for (int j = 0; j < 4; ++j) { const int n = (lane >> 3) + 8 * j; const LAS float* s = scr + (8 * c) * 33 + n;
        u32x4 o; o.x = cvt2(s[0 * 33], s[1 * 33]); o.y = cvt2(s[2 * 33], s[3 * 33]); o.z = cvt2(s[4 * 33], s[5 * 33]); o.w = cvt2(s[6 * 33], s[7 * 33]);
        *(GAS u32x4*)(WT + (size_t)(n0 + n) * K + k0 + 8 * c) = o; }
    asm volatile("s_waitcnt lgkmcnt(0)" ::: "memory");
}

__device__ __forceinline__ int crow(int r, int hi) { return (r & 3) + 8 * (r >> 2) + 4 * hi; }
__device__ __forceinline__ s16x4 vtr(const LAS unsigned char* p) { typedef short v4i16_t __attribute__((ext_vector_type(4)));
    return __builtin_bit_cast(s16x4, __builtin_amdgcn_ds_read_tr16_b64_v4i16((LAS v4i16_t*)p)); }
constexpr int ATT_KSLOT = 12288, ATT_VSLOT = 8192, ATT_VOFF = 2 * ATT_KSLOT;
struct AttT { const bf16_t *QN, *QR, *KN, *KR, *VV, *SZA; bf16_t* MG; };

__device__ __forceinline__ void attn_unit(int b, int h, int qb, const AttT& A, LAS unsigned char* lds) {
    int tid_ = threadIdx.x; asm volatile("" : "+v"(tid_));
    const int tid = tid_, lane = tid & 63, r32 = lane & 31, hi = lane >> 5;
    const int wid = __builtin_amdgcn_readfirstlane(tid >> 6);
    const size_t rowbase = (size_t)b * SEQ; const int q0 = qb * 256;
    const size_t qrow = rowbase + q0 + wid * 32 + r32;
    bf16x8 qf[6];
#pragma unroll
    for (int d0 = 0; d0 < 4; ++d0) qf[d0] = *(const GAS bf16x8*)(A.QN + qrow * 512 + h * 64 + d0 * 16 + hi * 8);
#pragma unroll
    for (int d0 = 0; d0 < 2; ++d0) qf[4 + d0] = *(const GAS bf16x8*)(A.QR + qrow * 256 + h * 32 + d0 * 16 + hi * 8);
    const int NT = (q0 + 256) / 64, tl = (q0 + wid * 32) >> 6;
    const bf16_t* kn_src = A.KN + (rowbase + lane) * 512 + h * 64 + wid * 8;
    const bf16_t* kr_src = A.KR + (rowbase + lane) * 32 + (wid & 3) * 8;
    const bf16_t* v_src = A.VV + (rowbase + (wid & 3) * 16 + (lane >> 2)) * 512 + h * 64 + (wid >> 2) * 32 + (lane & 3) * 8;
    const int kn_dst = wid * 1024 + lane * 16, kr_dst = (8 + (wid & 3)) * 1024 + lane * 16, v_dst = ATT_VOFF + wid * 1024 + lane * 16;
    u32x4 rk0, rk1 = (u32x4){0u, 0u, 0u, 0u}, rv;
#define ATT_LOAD(t) do { rk0 = *(const GAS u32x4*)(kn_src + (size_t)(t) * 64 * 512); if (wid < 4) rk1 = *(const GAS u32x4*)(kr_src + (size_t)(t) * 64 * 32); rv = *(const GAS u32x4*)(v_src + (size_t)(t) * 64 * 512); } while (0)
#define ATT_STORE(buf) do { *(LAS u32x4*)(lds + (buf) * ATT_KSLOT + kn_dst) = rk0; if (wid < 4) *(LAS u32x4*)(lds + (buf) * ATT_KSLOT + kr_dst) = rk1; *(LAS u32x4*)(lds + (buf) * ATT_VSLOT + v_dst) = rv; } while (0)
    ATT_LOAD(0); ATT_STORE(0);
    __syncthreads();
    float mref = 0.f, l_run = 0.f;
    f32x16 o0, o1, negm;
#pragma unroll
    for (int r = 0; r < 16; ++r) { o0[r] = 0.f; o1[r] = 0.f; negm[r] = 0.f; }
    const int kfb = hi * 1024 + r32 * 16;
    const int vfb = ATT_VOFF + (4 * hi + ((lane & 15) >> 2)) * 64 + ((lane >> 4) & 1) * 32 + (lane & 3) * 8;
    for (int t = 0; t < NT; ++t) {
        const int cur = t & 1;
        if (t + 1 < NT) ATT_LOAD(t + 1);
        if (t <= tl) {
            const LAS unsigned char* kb = lds + cur * ATT_KSLOT + kfb;
            const LAS unsigned char* vb = lds + cur * ATT_VSLOT + vfb;
            bf16x8 kf[12];
#pragma unroll
            for (int d0 = 0; d0 < 6; ++d0) { kf[2 * d0] = *(const LAS bf16x8*)(kb + d0 * 2048); kf[2 * d0 + 1] = *(const LAS bf16x8*)(kb + d0 * 2048 + 512); }
            __builtin_amdgcn_sched_barrier(0);
            f32x16 p0 = __builtin_amdgcn_mfma_f32_32x32x16_bf16(kf[0], qf[0], negm, 0, 0, 0), p1 = __builtin_amdgcn_mfma_f32_32x32x16_bf16(kf[1], qf[0], negm, 0, 0, 0);
#pragma unroll
            for (int d0 = 1; d0 < 6; ++d0) {
                p0 = __builtin_amdgcn_mfma_f32_32x32x16_bf16(kf[2 * d0], qf[d0], p0, 0, 0, 0);
                p1 = __builtin_amdgcn_mfma_f32_32x32x16_bf16(kf[2 * d0 + 1], qf[d0], p1, 0, 0, 0);
            }
            s16x4 vl[8], vh[8];
#pragma unroll
            for (int i = 0; i < 8; ++i) { vl[i] = vtr(vb + (i >> 2) * 4096 + (i & 3) * 1024); vh[i] = vtr(vb + (i >> 2) * 4096 + (i & 3) * 1024 + 512); }
            __builtin_amdgcn_sched_barrier(0);
            if (t == tl) {
                const int qrel = q0 + wid * 32 + r32 - 64 * t;
#pragma unroll
                for (int r = 0; r < 16; ++r) { const int kv = crow(r, hi); if (kv > qrel) p0[r] = -INFINITY; if (kv + 32 > qrel) p1[r] = -INFINITY; }
            }
#define MX3(a, b, c) __builtin_fmaxf(__builtin_fmaxf((a), (b)), (c))
            float ma = MX3(p0[0], p0[1], p1[0]), mb = MX3(p0[2], p0[3], p1[1]); ma = MX3(ma, p1[2], p1[3]);
#pragma unroll
            for (int r = 4; r < 16; r += 4) { ma = MX3(ma, p0[r], p0[r + 1]); mb = MX3(mb, p0[r + 2], p0[r + 3]); ma = MX3(ma, p1[r], p1[r + 1]); mb = MX3(mb, p1[r + 2], p1[r + 3]); }
#undef MX3
            float rm = fmaxf(ma, mb);
            { const auto rr = __builtin_amdgcn_permlane32_swap(__float_as_uint(rm), __float_as_uint(rm), false, false); rm = fmaxf(__uint_as_float(rr[0]), __uint_as_float(rr[1])); }
            if (t == 0 || __any(rm > 8.f)) {
                const float dl = (t == 0) ? rm : fmaxf(rm, 0.f);
                mref += dl;
#pragma unroll
                for (int r = 0; r < 16; ++r) { p0[r] -= dl; p1[r] -= dl; negm[r] = -mref; }
                if (t != 0) { const float f = __builtin_amdgcn_exp2f(-dl); l_run *= f;
#pragma unroll
                    for (int r = 0; r < 16; ++r) { o0[r] *= f; o1[r] *= f; } }
            }
            float ls = 0.f;
#pragma unroll
            for (int r = 0; r < 16; ++r) { p0[r] = __builtin_amdgcn_exp2f(p0[r]); p1[r] = __builtin_amdgcn_exp2f(p1[r]); ls += p0[r] + p1[r]; }
            l_run += ls;
            bf16x8 pf[4];
            { u32x4 w;
              w.x = cvt2(p0[0], p0[1]); w.y = cvt2(p0[2], p0[3]); w.z = cvt2(p0[4], p0[5]); w.w = cvt2(p0[6], p0[7]); pf[0] = __builtin_bit_cast(bf16x8, w);
              w.x = cvt2(p0[8], p0[9]); w.y = cvt2(p0[10], p0[11]); w.z = cvt2(p0[12], p0[13]); w.w = cvt2(p0[14], p0[15]); pf[1] = __builtin_bit_cast(bf16x8, w);
              w.x = cvt2(p1[0], p1[1]); w.y = cvt2(p1[2], p1[3]); w.z = cvt2(p1[4], p1[5]); w.w = cvt2(p1[6], p1[7]); pf[2] = __builtin_bit_cast(bf16x8, w);
              w.x = cvt2(p1[8], p1[9]); w.y = cvt2(p1[10], p1[11]); w.z = cvt2(p1[12], p1[13]); w.w = cvt2(p1[14], p1[15]); pf[3] = __builtin_bit_cast(bf16x8, w); }
            __builtin_amdgcn_sched_barrier(0);
#pragma unroll
            for (int ks = 0; ks < 4; ++ks) {
                const bf16x8 va = (bf16x8){vl[ks][0], vl[ks][1], vl[ks][2], vl[ks][3], vh[ks][0], vh[ks][1], vh[ks][2], vh[ks][3]};
                const bf16x8 vbq = (bf16x8){vl[4 + ks][0], vl[4 + ks][1], vl[4 + ks][2], vl[4 + ks][3], vh[4 + ks][0], vh[4 + ks][1], vh[4 + ks][2], vh[4 + ks][3]};
                o0 = __builtin_amdgcn_mfma_f32_32x32x16_bf16(va, pf[ks], o0, 0, 0, 0);
                o1 = __builtin_amdgcn_mfma_f32_32x32x16_bf16(vbq, pf[ks], o1, 0, 0, 0);
            }
        }
        if (t + 1 < NT) ATT_STORE(cur ^ 1);
        __syncthreads();
    }
#undef ATT_LOAD
#undef ATT_STORE
    float lt = l_run; { const auto rr = __builtin_amdgcn_permlane32_swap(__float_as_uint(lt), __float_as_uint(lt), false, false); lt = __uint_as_float(rr[0]) + __uint_as_float(rr[1]); }
    const float inv = 1.f / lt;
    const bf16_t* zrow = A.SZA + qrow * 512 + h * 64; bf16_t* orow = A.MG + qrow * 1024 + h * 64;
#pragma unroll
    for (int j = 0; j < 4; ++j) { const int d = 8 * j + 4 * hi;
        const f32x4 z0 = unpack4(*(const GAS u32x2*)(zrow + d)), z1 = unpack4(*(const GAS u32x2*)(zrow + 32 + d));
        const f32x4 a = (f32x4){o0[4 * j], o0[4 * j + 1], o0[4 * j + 2], o0[4 * j + 3]} * inv * z0, c = (f32x4){o1[4 * j], o1[4 * j + 1], o1[4 * j + 2], o1[4 * j + 3]} * inv * z1;
        *(GAS u32x2*)(orow + d) = pack4(a); *(GAS u32x2*)(orow + 32 + d) = pack4(c); }
}

struct SguT { const bf16_t *GV, *GU, *SZB, *WSP; const GAS float *VSTAT, *g, *bta, *bsp; bf16_t* MG; };
__device__ __forceinline__ void sgu_unit(int chunk, int h, const SguT& S, LAS unsigned char* lds) {
    int tid_ = threadIdx.x; asm volatile("" : "+v"(tid_));
    const int tid = tid_, lane = tid & 63, r32 = lane & 31, hi = lane >> 5;
    const int wid = __builtin_amdgcn_readfirstlane(tid >> 6);
    const size_t row0 = (size_t)chunk * 128;
    {
        const int s = tid >> 2, ch = tid & 3; const size_t row = row0 + s;
        const GAS f32x4* st = (const GAS f32x4*)(S.VSTAT + row * 16);
        const f32x4 a = st[0], b = st[1], c = st[2], d = st[3];
        const float s1 = (a[0] + a[2]) + (b[0] + b[2]) + (c[0] + c[2]) + (d[0] + d[2]), s2 = (a[1] + a[3]) + (b[1] + b[3]) + (c[1] + c[3]) + (d[1] + d[3]);
        const float mean = s1 * (1.f / 512.f), var = fmaxf(s2 * (1.f / 512.f) - mean * mean, 0.f), rstd = 1.f / sqrtf(var + EPS);
#pragma unroll
        for (int dh = 0; dh < 2; ++dh) { const int c0 = h * 64 + dh * 32 + ch * 8;
            const u32x4 raw = *(const GAS u32x4*)(S.GV + row * 512 + c0);
            const f32x4 g0 = *(const GAS f32x4*)(S.g + c0), g1 = *(const GAS f32x4*)(S.g + c0 + 4), b0 = *(const GAS f32x4*)(S.bta + c0), b1 = *(const GAS f32x4*)(S.bta + c0 + 4);
            f32x4 v0 = (f32x4){bf_lo(raw.x), bf_hi(raw.x), bf_lo(raw.y), bf_hi(raw.y)}, v1 = (f32x4){bf_lo(raw.z), bf_hi(raw.z), bf_lo(raw.w), bf_hi(raw.w)};
            v0 = (v0 - mean) * rstd * g0 + b0; v1 = (v1 - mean) * rstd * g1 + b1;
            *(LAS u32x4*)(lds + dh * 8192 + s * 64 + ch * 16) = pack8(v0, v1); }
    }
    __syncthreads();
    const int db = wid & 1, tb = wid >> 1, t = 32 * tb + r32, nks = 2 * tb + 2;
    f32x16 acc;
#pragma unroll
    for (int r = 0; r < 16; ++r) acc[r] = 0.f;
    const LAS unsigned char* vb = lds + db * 8192 + (8 * hi + ((lane & 15) >> 2)) * 64 + ((lane >> 4) & 1) * 32 + (lane & 3) * 8;
    const bf16_t* wrow = S.WSP + ((size_t)h * 128 + t) * 128 + 8 * hi;
    for (int ks = 0; ks < nks; ++ks) {
        const s16x4 a0 = vtr(vb + ks * 1024), a1 = vtr(vb + ks * 1024 + 256);
        const bf16x8 va = (bf16x8){a0[0], a0[1], a0[2], a0[3], a1[0], a1[1], a1[2], a1[3]};
        const bf16x8 wf = *(const GAS bf16x8*)(wrow + 16 * ks);
        acc = __builtin_amdgcn_mfma_f32_32x32x16_bf16(va, wf, acc, 0, 0, 0);
    }
    const float bias = S.bsp[h * 128 + t];
    const size_t row = row0 + t; const int cbase = h * 64 + 32 * db;
#pragma unroll
    for (int j = 0; j < 4; ++j) { const int c = cbase + 8 * j + 4 * hi;
        const f32x4 gu = unpack4(*(const GAS u32x2*)(S.GU + row * 512 + c)), zb = unpack4(*(const GAS u32x2*)(S.SZB + row * 512 + c));
        const f32x4 sv = (f32x4){acc[4 * j], acc[4 * j + 1], acc[4 * j + 2], acc[4 * j + 3]} + bias;
        *(GAS u32x2*)(S.MG + row * 1024 + 512 + c) = pack4(sv * gu * zb); }
    __syncthreads();
}

#define XB_TMO      128
#define XB_XCNT(j)  (256  + 64 * (j))
#define XB_XSUB(j)  (1280 + 64 * (j))
#define XB_XGEN(j)  (2304 + 64 * (j))
#define XB_TOP      3328
#define XB_TOPGEN   3392
#define XCD_BAR_WORDS 3456
#define XB_SPIN_CAP (1u << 18)

__device__ __forceinline__ unsigned xb_ld(unsigned* p)              { return __hip_atomic_load(p, __ATOMIC_RELAXED, __HIP_MEMORY_SCOPE_AGENT); }
__device__ __forceinline__ unsigned xb_add(unsigned* p, unsigned v) { return __hip_atomic_fetch_add(p, v, __ATOMIC_RELAXED, __HIP_MEMORY_SCOPE_AGENT); }
__device__ __forceinline__ unsigned xb_xcc_id() { return (unsigned)__builtin_amdgcn_s_getreg((3 << 11) | 20) & 0xFu; }
#define XB_SPIN(cond, bar) do { unsigned _sp = 0; while (cond) { __builtin_amdgcn_s_sleep(1); \
    if ((++_sp & 255u) == 0u) { if (xb_ld(&(bar)[XB_TMO])) break; if (_sp > XB_SPIN_CAP) { atomicAdd(&(bar)[XB_TMO], 1u); break; } } } } while (0)

struct XcdBarrier {
    unsigned* bar; unsigned x;
    volatile LAS unsigned* st;
};

__device__ __forceinline__ XcdBarrier xcd_barrier_post(unsigned* bar, volatile LAS unsigned* st) {
    XcdBarrier b; b.bar = bar; b.x = xb_xcc_id(); b.st = st;
    if (threadIdx.x == 0) (void)xb_add(&bar[XB_XCNT(b.x)], 1u);
    return b;
}
__device__ __forceinline__ void xcd_barrier_complete(unsigned* bar, unsigned x, unsigned& nloc, unsigned& nx) {
    const unsigned G = gridDim.x * gridDim.y * gridDim.z;
    unsigned sum, cnt, mine, sp = 0u;
    for (;;) {
        sum = 0u; cnt = 0u; mine = 0u;
#pragma unroll
        for (unsigned j = 0; j < 16; ++j) { const unsigned c = xb_ld(&bar[XB_XCNT(j)]); sum += c; cnt += (c > 0u) ? 1u : 0u; mine = (j == x) ? c : mine; }
        if (sum == G) break;
        __builtin_amdgcn_s_sleep(1);
        if ((++sp & 255u) == 0u) { if (xb_ld(&bar[XB_TMO])) break; if (sp > XB_SPIN_CAP) { atomicAdd(&bar[XB_TMO], 1u); break; } }
    }
    nloc = mine > 0u ? mine : 1u; nx = cnt > 0u ? cnt : 1u;
}

__device__ __forceinline__ void xcd_barrier(const XcdBarrier& b) {
    asm volatile("s_waitcnt vmcnt(0)" ::: "memory");
    __syncthreads();
    if (threadIdx.x == 0) {
        unsigned* bar = b.bar;
        __builtin_amdgcn_s_waitcnt(0);
        unsigned nloc = b.st[0], nx = b.st[1];
        if (nloc == 0u) { xcd_barrier_complete(bar, b.x, nloc, nx); b.st[0] = nloc; b.st[1] = nx; }
        const unsigned old = xb_add(&bar[XB_XSUB(b.x)], 1u);
        const unsigned gen = old / nloc;
        if (old + 1u == (gen + 1u) * nloc) {
            __builtin_amdgcn_fence(__ATOMIC_RELEASE, "agent");
            asm volatile("s_waitcnt vmcnt(0)" ::: "memory");
            const unsigned og = xb_add(&bar[XB_TOP], 1u);
            const unsigned tg = og / nx;
            if (og + 1u == (tg + 1u) * nx) xb_add(&bar[XB_TOPGEN], 1u);
            else XB_SPIN(xb_ld(&bar[XB_TOPGEN]) == tg, bar);
            __builtin_amdgcn_fence(__ATOMIC_ACQUIRE, "agent");
            xb_add(&bar[XB_XGEN(b.x)], 1u);
            asm volatile("s_waitcnt vmcnt(0)" ::: "memory");
        } else {
            XB_SPIN(xb_ld(&bar[XB_XGEN(b.x)]) == gen, bar);
            __builtin_amdgcn_fence(__ATOMIC_ACQUIRE, "agent");
            asm volatile("s_waitcnt vmcnt(0)" ::: "memory");
        }
    }
    __syncthreads();
}

struct Args { const float* in[14]; float* out; unsigned char* ws; int ph_lo, ph_hi; };
static_assert(WS_GU - WS_SZA == 32 * MiB && WS_GV - WS_GU == 32 * MiB && WS_SZB - WS_GV == 32 * MiB && WS_VV - WS_KN == 32 * MiB, "epilogue pointer arithmetic");
static_assert(sizeof(Args) == 14 * 8 + 8 + 8 + 8, "Args has no padding");

__global__ void __launch_bounds__(NTHREADS, 2) mk_fwd(Args args) {
    extern __shared__ __attribute__((aligned(16))) unsigned char lds_raw[];
    LAS unsigned char* lds = (LAS unsigned char*)lds_raw;
    if (threadIdx.x < 32) ((LAS unsigned*)(lds + 131072))[threadIdx.x + 64] = 0u;
    __syncthreads();
    XcdBarrier bar = xcd_barrier_post((unsigned*)(args.ws + WS_BAR), (volatile LAS unsigned*)(lds + LDS_MISC));
    if (args.ph_lo < 0) cg::this_grid().sync();
    const int G = gridDim.x, bx = blockIdx.x, vcu = (G % 8 == 0) ? (bx % 8) * (G / 8) + bx / 8 : bx;
    const int lo = args.ph_lo, hi = args.ph_hi;
    const float* x = args.in[0]; const int* pos = (const int*)args.in[1];
#define WSPTR(name, type, off) unsigned char* name##_b = args.ws; asm volatile("" : "+s"(name##_b)); type* name = (type*)(name##_b + (off))
#ifndef MK_REP
#define MK_REP 0
#endif
#define REP(k) for (int rep_ = 0; rep_ < 1 + ((MK_REP >> (k)) & 1); ++rep_)
#ifndef MK_PHASES
#define MK_PHASES 63
#endif
#define IN(k) (((MK_PHASES >> (k)) & 1) && lo <= (k) && (k) < hi)
#define SEAM(k) do { if (IN(k) && IN((k) + 1)) { xcd_barrier(bar); } } while (0)

    if (IN(0)) REP(0) {
        const float *w_in = args.in[2], *q_g = args.in[3], *w_uq = args.in[4], *kv_g = args.in[5], *w_ukv = args.in[6], *w_sp = args.in[9], *w_out = args.in[11];
        WSPTR(WIN, bf16_t, WS_WIN); bf16_t *WUQ = WIN + (WS_WUQ - WS_WIN) / 2, *WUKV = WIN + (WS_WUKV - WS_WIN) / 2, *WOUT = WIN + (WS_WOUT - WS_WIN) / 2, *WSP = WIN + (WS_WSP - WS_WIN) / 2, *XB = WIN + (WS_XB - WS_WIN) / 2;
        int tid = threadIdx.x; asm volatile("" : "+v"(tid)); const int lane = tid & 63, wave = __builtin_amdgcn_readfirstlane(tid >> 6);
        LAS float* scr = (LAS float*)(lds + wave * 16384);
        const int gw = vcu * NWAVES + wave, NGW = G * NWAVES;
        constexpr int I_IN = (DM / 64) * (N_IN / 32), I_UQ = (256 / 64) * (768 / 32), I_UKV = (128 / 64) * (1024 / 32), I_OUT = (DM / 64) * (DM / 32);
        for (int it = gw; it < I_IN + I_UQ + I_UKV + I_OUT; it += NGW) {
            int r = it;
            if (r < I_IN) { transpose_item((const GAS float*)w_in, DM, D_IN, N_IN, WIN, 0, nullptr, scr, r, lane); continue; } r -= I_IN;
            if (r < I_UQ) { transpose_item((const GAS float*)w_uq, 256, 768, 768, WUQ, 1, (const GAS float*)q_g, scr, r, lane); continue; } r -= I_UQ;
            if (r < I_UKV) { transpose_item((const GAS float*)w_ukv, 128, 1024, 1024, WUKV, 2, (const GAS float*)kv_g, scr, r, lane); continue; } r -= I_UKV;
            transpose_item((const GAS float*)w_out, DM, DM, DM, WOUT, 3, nullptr, scr, r, lane);
        }
        const int gt = vcu * NTHREADS + tid, NGT = G * NTHREADS;
        for (int i = gt; i < NH * 128 * 128 / 8; i += NGT) {
            const int e = i * 8, tt = (e >> 7) & 127, s0 = e & 127;
            const f32x4 a = *(const GAS f32x4*)(w_sp + e), b = *(const GAS f32x4*)(w_sp + e + 4); f32x4 a2, b2;
#pragma unroll
            for (int j = 0; j < 4; ++j) { a2[j] = (s0 + j <= tt) ? a[j] : 0.f; b2[j] = (s0 + 4 + j <= tt) ? b[j] : 0.f; }
            *(GAS u32x4*)(WSP + e) = pack8(a2, b2);
        }
        for (int i = gt; i < T * DM / 8; i += NGT) {
            const f32x4 a = *(const GAS f32x4*)(x + (size_t)i * 8), b = *(const GAS f32x4*)(x + (size_t)i * 8 + 4);
            *(GAS u32x4*)(XB + (size_t)i * 8) = pack8(a, b);
        }
    }
    SEAM(0);
    if (IN(1)) REP(1) {
        WSPTR(WIN, bf16_t, WS_WIN); bf16_t *XB = WIN + (WS_XB - WS_WIN) / 2, *CQ = WIN + (WS_CQ - WS_WIN) / 2, *CKV = WIN + (WS_CKV - WS_WIN) / 2, *KR = WIN + (WS_KR - WS_WIN) / 2, *SZA = WIN + (WS_SZA - WS_WIN) / 2;
        float *SSQQ = (float*)(WIN + (WS_SSQQ - WS_WIN) / 2), *SSQKV = (float*)(WIN + (WS_SSQKV - WS_WIN) / 2), *VSTAT = (float*)(WIN + (WS_VSTAT - WS_WIN) / 2);
        pg8::Gemm g{XB, WIN, T, N_IN, DM}; pg8::StaticOrder S; S.init(T, N_IN, G, bx);
        EpiInProj E{CQ, CKV, KR, SZA, (GAS float*)SSQQ, (GAS float*)SSQKV, (GAS float*)VSTAT, (const GAS int*)pos};
        pg8::gemm_phase<EpiInProj, pg8::StaticOrder, true, true>(lds, g, S, E);
    }
    SEAM(1);
    if (IN(2)) REP(2) {
        WSPTR(WIN, bf16_t, WS_WIN); bf16_t *WUQ = WIN + (WS_WUQ - WS_WIN) / 2, *WUKV = WIN + (WS_WUKV - WS_WIN) / 2, *CQ = WIN + (WS_CQ - WS_WIN) / 2, *CKV = WIN + (WS_CKV - WS_WIN) / 2, *QN = WIN + (WS_QN - WS_WIN) / 2, *QR = WIN + (WS_QR - WS_WIN) / 2, *KN = WIN + (WS_KN - WS_WIN) / 2;
        float *SSQQ = (float*)(WIN + (WS_SSQQ - WS_WIN) / 2), *SSQKV = (float*)(WIN + (WS_SSQKV - WS_WIN) / 2);
        { pg8::Gemm g{CQ, WUQ, T, 768, 256}; pg8::StaticOrder S; S.init(T, 768, G, bx);
          EpiQUp E{QN, QR, (const GAS float*)SSQQ, (const GAS int*)pos};
          pg8::gemm_phase<EpiQUp, pg8::StaticOrder, true, true>(lds, g, S, E); }
        { pg8::Gemm g{CKV, WUKV, T, 1024, 128}; pg8::StaticOrder S; S.init(T, 1024, G, bx);
          EpiKVUp E{KN, (const GAS float*)SSQKV};
          pg8::gemm_phase<EpiKVUp, pg8::StaticOrder, true, true>(lds, g, S, E); }
    }
    SEAM(2);
    if (IN(3)) {
        const float *sgu_g = args.in[7], *sgu_b = args.in[8], *b_sp = args.in[10];
        WSPTR(WIN, bf16_t, WS_WIN); bf16_t *WSP = WIN + (WS_WSP - WS_WIN) / 2, *KR = WIN + (WS_KR - WS_WIN) / 2, *SZA = WIN + (WS_SZA - WS_WIN) / 2, *GU = WIN + (WS_GU - WS_WIN) / 2, *GV = WIN + (WS_GV - WS_WIN) / 2, *SZB = WIN + (WS_SZB - WS_WIN) / 2,
            *QN = WIN + (WS_QN - WS_WIN) / 2, *QR = WIN + (WS_QR - WS_WIN) / 2, *KN = WIN + (WS_KN - WS_WIN) / 2, *VV = WIN + (WS_VV - WS_WIN) / 2, *MG = WIN + (WS_MG - WS_WIN) / 2;
        float* VSTAT = (float*)(WIN + (WS_VSTAT - WS_WIN) / 2);
        const AttT A{QN, QR, KN, KR, VV, SZA, MG};
        REP(3) for (int idx = vcu; idx < BATCH * NH * 32; idx += G) {
            const int i = idx >> 8, v = idx & 255, bh = v >> 3, s = v & 7;
            const int qb = (i == 0) ? s : (i == 1) ? 15 - s : (i == 2) ? 16 + s : 31 - s;
            attn_unit(bh >> 3, bh & 7, qb, A, lds);
        }
        const SguT Sg{GV, GU, SZB, WSP, (const GAS float*)VSTAT, (const GAS float*)sgu_g, (const GAS float*)sgu_b, (const GAS float*)b_sp, MG};
        REP(6) for (int idx = vcu; idx < (T / 128) * NH; idx += G) sgu_unit(idx >> 3, idx & 7, Sg, lds);
    }
    SEAM(3);
    if (IN(4)) REP(4) {
        WSPTR(WIN, bf16_t, WS_WIN); bf16_t *WOUT = WIN + (WS_WOUT - WS_WIN) / 2, *MG = WIN + (WS_MG - WS_WIN) / 2;
        pg8::Gemm g{MG, WOUT, T, DM, DM}; pg8::StaticOrder S; S.init(T, DM, G, bx);
        EpiOut E{x, args.out};
        pg8::gemm_phase<EpiOut, pg8::StaticOrder, true, true>(lds, g, S, E);
    }
    SEAM(4);
    if (IN(5)) REP(5) {
        const float *ln_g = args.in[12], *ln_b = args.in[13];
        int tid = threadIdx.x; asm volatile("" : "+v"(tid)); const int lane = tid & 63, wave = __builtin_amdgcn_readfirstlane(tid >> 6);
        const int gw = vcu * NWAVES + wave, NGW = G * NWAVES;
        f32x4 gg[4], bb[4];
#pragma unroll
        for (int j = 0; j < 4; ++j) { gg[j] = *(const GAS f32x4*)(ln_g + 4 * lane + 256 * j); bb[j] = *(const GAS f32x4*)(ln_b + 4 * lane + 256 * j); }
        for (int m = gw; m < T; m += NGW) {
            GAS f32x4* rowp = (GAS f32x4*)(args.out + (size_t)m * DM) + lane;
            f32x4 v[4]; float s = 0.f;
#pragma unroll
            for (int j = 0; j < 4; ++j) { v[j] = rowp[64 * j]; s += sum4(v[j]); }
            const float mean = wave_sum(s) * (1.f / DM); float s2 = 0.f;
#pragma unroll
            for (int j = 0; j < 4; ++j) { v[j] = v[j] - mean; s2 += ssq4(v[j]); }
            const float rstd = 1.f / sqrtf(wave_sum(s2) * (1.f / DM) + EPS);
#pragma unroll
            for (int j = 0; j < 4; ++j) rowp[64 * j] = v[j] * rstd * gg[j] + bb[j];
        }
    }
#undef IN
#undef SEAM
}
}

extern "C" void kernel_launch(void* const* d_in, const int* in_sizes, int n_in, void* d_out, int out_size, void* d_ws, size_t ws_size, hipStream_t stream) {
    using namespace mk;
    static int grid = 0;
    if (grid == 0) {
        if (n_in != 14 || in_sizes[0] != T * DM || out_size != T * DM || ws_size < WS_END) {
            fprintf(stderr, "kernel_launch: unexpected problem (n_in %d, in0 %d, out %d, ws %zu)\n", n_in, n_in > 0 ? in_sizes[0] : -1, out_size, ws_size); grid = -1; return; }
        int dev = 0, cus = 0, per_cu = 0;
        if (hipGetDevice(&dev) != hipSuccess || hipDeviceGetAttribute(&cus, hipDeviceAttributeMultiprocessorCount, dev) != hipSuccess) { grid = -1; return; }
        if (hipFuncSetAttribute((const void*)mk_fwd, hipFuncAttributeMaxDynamicSharedMemorySize, LDS_BYTES) != hipSuccess) { fprintf(stderr, "kernel_launch: hipFuncSetAttribute failed\n"); grid = -1; return; }
        if (hipOccupancyMaxActiveBlocksPerMultiprocessor(&per_cu, (const void*)mk_fwd, NTHREADS, LDS_BYTES) != hipSuccess || per_cu < 1) {
            fprintf(stderr, "kernel_launch: occupancy query reports %d workgroups per CU\n", per_cu); (void)hipGetLastError(); grid = -1; return; }
        grid = cus;
    }
    if (grid < 0) return;
    if (hipMemsetAsync((char*)d_ws + WS_BAR, 0, BAR_BYTES, stream) != hipSuccess) { fprintf(stderr, "kernel_launch: memset failed\n"); return; }
    Args a{};
    for (int i = 0; i < 14; ++i) a.in[i] = (const float*)d_in[i];
    a.out = (float*)d_out; a.ws = (unsigned char*)d_ws;
#if MK_SPLIT
    for (int p = 0; p < 6; ++p) { a.ph_lo = p; a.ph_hi = p + 1; hipLaunchKernelGGL(mk_fwd, dim3(grid), dim3(NTHREADS), LDS_BYTES, stream, a); }
#else
    a.ph_lo = 0; a.ph_hi = 6;
    void* kargs[] = {&a};
    const hipError_t e = hipLaunchCooperativeKernel((const void*)mk_fwd, dim3(grid), dim3(NTHREADS), kargs, LDS_BYTES, stream);
    if (e != hipSuccess) fprintf(stderr, "kernel_launch: cooperative launch failed: %s (grid %d)\n", hipGetErrorString(e), grid);
#endif
}
```
